# Optimizing an MI355X kernel written in HIP

```python
import math
import jax, jax.numpy as jnp
from jax import lax
import numpy as np

D_MODEL = 1024
BATCH = 8
SEQ = 2048
DEPTH = 2
DEC_BATCH = 128
DEC_SEQ = 8
PAST_LEN = 16384
PAGE_SIZE = 128

W_A = D_MODEL
H_A = 16
HD_A = W_A // H_A
CONV_A = 4
LRU_C = 8.0
W_B = D_MODEL
G_B = 16
GD_B = W_B // G_B
CHUNK = 128
W_C = D_MODEL
CONV_C = 3
D_FF = 4 * D_MODEL
N_MOD = 6
IN_SPLITS = (W_A, W_B, W_B, W_C, W_C, W_C, D_MODEL, D_MODEL, D_MODEL)
IN_COLS = sum(IN_SPLITS)
EPS = 1e-6

kernel_name = "hybrid_rglru_chunkmlp_shortconv_decoder_step"


def rmsnorm(x, g):
    xf = x.astype(jnp.float32)
    y = xf * lax.rsqrt(jnp.mean(xf * xf, axis=-1, keepdims=True) + EPS)
    return (y * g.astype(jnp.float32)).astype(x.dtype)


def layernorm(x, g, b):
    xf = x.astype(jnp.float32)
    mu = jnp.mean(xf, axis=-1, keepdims=True)
    var = jnp.mean(jnp.square(xf - mu), axis=-1, keepdims=True)
    y = (xf - mu) * lax.rsqrt(var + EPS)
    return (y * g.astype(jnp.float32) + b.astype(jnp.float32)).astype(x.dtype)


def causal_conv(x, prev, w, b=None):
    K = w.shape[0]
    T = x.shape[1]
    xp = jnp.concatenate([prev.astype(x.dtype), x], axis=1)
    y = xp[:, 0:T] * w[0]
    for k in range(1, K):
        y = y + xp[:, k:k + T] * w[k]
    if b is not None:
        y = y + b
    return y, xp[:, -(K - 1):]


def rg_lru(xc, h0, wa, ba, wx, bx, lam):
    B, T, W = xc.shape
    xh = xc.reshape(B, T, H_A, HD_A)
    gate_r = jax.nn.sigmoid(jnp.einsum('bthi,hij->bthj', xh, wa).reshape(B, T, W) + ba)
    gate_i = jax.nn.sigmoid(jnp.einsum('bthi,hij->bthj', xh, wx).reshape(B, T, W) + bx)
    log_a = -LRU_C * gate_r.astype(jnp.float32) * jax.nn.softplus(-lam.astype(jnp.float32))
    a = jnp.exp(log_a)
    mult = jnp.sqrt(-jnp.expm1(2.0 * log_a))
    bterm = mult * (gate_i * xc).astype(jnp.float32)
    bterm = bterm.at[:, 0].add(a[:, 0] * h0.astype(jnp.float32))

    def combine(left, right):
        al, bl = left
        ar, br = right
        return al * ar, ar * bl + br

    _, hs = lax.associative_scan(combine, (a, bterm), axis=1)
    return hs.astype(xc.dtype), hs[:, -1]


def chunk_mix(v, ws, bs):
    B, T, W = v.shape
    n_chunks = -(-T // CHUNK)
    t_pad = n_chunks * CHUNK
    vp = jnp.pad(v, ((0, 0), (0, t_pad - T), (0, 0)))
    vr = vp.reshape(B, n_chunks, CHUNK, G_B, GD_B)
    mask = jnp.tril(jnp.ones((CHUNK, CHUNK), dtype=bool))
    wm = jnp.where(mask[None], ws, jnp.zeros((), ws.dtype))
    out = jnp.einsum('gts,bnsgc->bntgc', wm, vr) + jnp.transpose(bs)[None, None, :, :, None]
    return out.reshape(B, t_pad, W)[:, :T]


def trunk_layer(x, c, h0, lconv0, sconv0, w_ada, b_ada, g_norm1, g_norm2, w_in,
                lru_conv_w, lru_conv_b, lru_wa, lru_ba, lru_wx, lru_bx, lru_lambda,
                cm_ln_g, cm_ln_b, cm_ws, cm_bs, sc_conv_w,
                w_br_a, w_br_b, w_br_c, w_o, w_ff1, w_ff2):
    mod = jax.nn.silu(c) @ w_ada + b_ada
    shift1, scale1, gate1, shift2, scale2, gate2 = [m[:, None, :] for m in jnp.split(mod, N_MOD, axis=-1)]

    h = rmsnorm(x, g_norm1) * (1.0 + scale1) + shift1
    z = h @ w_in
    idx = np.cumsum(IN_SPLITS)[:-1].tolist()
    xa, u, v, gb, gc, xc, g_a, g_b, g_c = jnp.split(z, idx, axis=-1)

    xa_c, lconv_new = causal_conv(xa, lconv0, lru_conv_w, lru_conv_b)
    ya, h_last = rg_lru(xa_c, h0, lru_wa, lru_ba, lru_wx, lru_bx, lru_lambda)

    vn = layernorm(v, cm_ln_g, cm_ln_b)
    yb = u * chunk_mix(vn, cm_ws, cm_bs)

    q = gc * xc
    qc, sconv_new = causal_conv(q, sconv0, sc_conv_w)
    yc = gb * qc

    merged = (jax.nn.sigmoid(g_a) * (ya @ w_br_a)
              + jax.nn.sigmoid(g_b) * (yb @ w_br_b)
              + jax.nn.sigmoid(g_c) * (yc @ w_br_c))
    x = x + gate1 * (merged @ w_o)

    h2 = rmsnorm(x, g_norm2) * (1.0 + scale2) + shift2
    ff = jnp.square(jax.nn.relu(h2 @ w_ff1)) @ w_ff2
    x = x + gate2 * ff
    return x, h_last, lconv_new, sconv_new, vn


def setup_inputs(seed: int = 0) -> dict:
    key = jax.random.key(seed)
    ks = iter(jax.random.split(key, 40))
    f32 = jnp.float32

    def nrm(shape, scale):
        return jax.random.normal(next(ks), shape, f32) * scale

    a_init = jax.random.uniform(next(ks), (DEPTH, W_A), f32, 0.9, 0.999)
    inp = {
        "x_prompt": nrm((BATCH, SEQ, D_MODEL), 1.0),
        "x_sample": nrm((DEC_BATCH, DEC_SEQ, D_MODEL), 1.0),
        "c_prompt": nrm((BATCH, D_MODEL), 1.0),
        "c_sample": nrm((DEC_BATCH, D_MODEL), 1.0),
        "state_lru_h": nrm((DEPTH, DEC_BATCH, W_A), 0.5),
        "state_lru_conv": nrm((DEPTH, DEC_BATCH, CONV_A - 1, W_A), 1.0),
        "state_sconv": nrm((DEPTH, DEC_BATCH, CONV_C - 1, W_C), 1.0),
        "w_ada": nrm((DEPTH, D_MODEL, N_MOD * D_MODEL), D_MODEL ** -0.5),
        "b_ada": nrm((DEPTH, N_MOD * D_MODEL), 0.01),
        "g_norm1": 1.0 + nrm((DEPTH, D_MODEL), 0.02),
        "g_norm2": 1.0 + nrm((DEPTH, D_MODEL), 0.02),
        "g_final": 1.0 + nrm((D_MODEL,), 0.02),
        "w_in": nrm((DEPTH, D_MODEL, IN_COLS), D_MODEL ** -0.5),
        "lru_conv_w": nrm((DEPTH, CONV_A, W_A), CONV_A ** -0.5),
        "lru_conv_b": nrm((DEPTH, W_A), 0.01),
        "lru_wa": nrm((DEPTH, H_A, HD_A, HD_A), HD_A ** -0.5),
        "lru_ba": nrm((DEPTH, W_A), 0.01),
        "lru_wx": nrm((DEPTH, H_A, HD_A, HD_A), HD_A ** -0.5),
        "lru_bx": nrm((DEPTH, W_A), 0.01),
        "lru_lambda": jnp.log(a_init) - jnp.log1p(-a_init),
        "cm_ln_g": 1.0 + nrm((DEPTH, W_B), 0.02),
        "cm_ln_b": nrm((DEPTH, W_B), 0.01),
        "cm_ws": nrm((DEPTH, G_B, CHUNK, CHUNK), CHUNK ** -0.5),
        "cm_bs": 1.0 + nrm((DEPTH, G_B, CHUNK), 0.01),
        "sc_conv_w": nrm((DEPTH, CONV_C, W_C), CONV_C ** -0.5),
        "w_br_a": nrm((DEPTH, W_A, D_MODEL), W_A ** -0.5),
        "w_br_b": nrm((DEPTH, W_B, D_MODEL), W_B ** -0.5),
        "w_br_c": nrm((DEPTH, W_C, D_MODEL), W_C ** -0.5),
        "w_o": nrm((DEPTH, D_MODEL, D_MODEL), D_MODEL ** -0.5),
        "w_ff1": nrm((DEPTH, D_MODEL, D_FF), D_MODEL ** -0.5),
        "w_ff2": nrm((DEPTH, D_FF, D_MODEL), D_FF ** -0.5),
    }
    return inp


def reference(x_prompt, x_sample, c_prompt, c_sample, state_lru_h, state_lru_conv, state_sconv,
              w_ada, b_ada, g_norm1, g_norm2, g_final, w_in, lru_conv_w, lru_conv_b,
              lru_wa, lru_ba, lru_wx, lru_bx, lru_lambda, cm_ln_g, cm_ln_b, cm_ws, cm_bs,
              sc_conv_w, w_br_a, w_br_b, w_br_c, w_o, w_ff1, w_ff2):
    xp, xs = x_prompt, x_sample
    bp = x_prompt.shape[0]
    hp_l, lcp_l, scp_l = [], [], []
    hs_l, lcs_l, scs_l, vs_l = [], [], [], []
    for l in range(DEPTH):
        weights = (w_ada[l], b_ada[l], g_norm1[l], g_norm2[l], w_in[l],
                   lru_conv_w[l], lru_conv_b[l], lru_wa[l], lru_ba[l], lru_wx[l], lru_bx[l],
                   lru_lambda[l], cm_ln_g[l], cm_ln_b[l], cm_ws[l], cm_bs[l], sc_conv_w[l],
                   w_br_a[l], w_br_b[l], w_br_c[l], w_o[l], w_ff1[l], w_ff2[l])
        h0p = jnp.zeros((bp, W_A), jnp.float32)
        lc0p = jnp.zeros((bp, CONV_A - 1, W_A), xp.dtype)
        sc0p = jnp.zeros((bp, CONV_C - 1, W_C), xp.dtype)
        xp, hp, lcp, scp, _vp = trunk_layer(xp, c_prompt, h0p, lc0p, sc0p, *weights)
        hp_l.append(hp); lcp_l.append(lcp); scp_l.append(scp)
        xs, hs, lcs, scs, vs = trunk_layer(xs, c_sample, state_lru_h[l], state_lru_conv[l],
                                           state_sconv[l], *weights)
        hs_l.append(hs); lcs_l.append(lcs); scs_l.append(scs); vs_l.append(vs)
    y_prompt = rmsnorm(xp, g_final)
    y_sample = rmsnorm(xs, g_final)
    return (y_prompt, y_sample,
            jnp.stack(hp_l), jnp.stack(lcp_l), jnp.stack(scp_l),
            jnp.stack(hs_l), jnp.stack(lcs_l), jnp.stack(scs_l), jnp.stack(vs_l))
```

```cpp
#include <hip/hip_runtime.h>
#include <hip/hip_cooperative_groups.h>
#include <cstdio>
#include <cstdint>
namespace cg = cooperative_groups;

#define LAS __attribute__((address_space(3)))
typedef unsigned short bf16_t;
typedef short bf16x8 __attribute__((ext_vector_type(8)));
typedef float f32x4 __attribute__((ext_vector_type(4)));
typedef float f32x2 __attribute__((ext_vector_type(2)));
typedef unsigned u32x4 __attribute__((ext_vector_type(4)));
typedef unsigned u32x2 __attribute__((ext_vector_type(2)));
typedef int i32x4 __attribute__((ext_vector_type(4)));
typedef int i32x8 __attribute__((ext_vector_type(8)));

constexpr int D = 1024, NBATCH = 136, MH = 8704, MT = 17408, INC = 9216, DFF = 4096;
constexpr float EPS = 1e-6f;
constexpr size_t O_YP = 0, O_HP = 17825792, O_LCP = O_HP + 16384, O_SCP = O_LCP + 49152, O_HS = O_SCP + 32768,
                 O_LCS = O_HS + 262144, O_SCS = O_LCS + 786432, O_VS = O_SCS + 524288;
constexpr size_t WS_WIN = 0;
constexpr size_t WS_WBR = WS_WIN + 2ull * 6144 * 1024 * 2;
constexpr size_t WS_WO3 = WS_WBR + 2ull * 3 * 1024 * 1024 * 2;
constexpr size_t WS_WF1 = WS_WO3 + 2ull * 1024 * 1024 * 2;
constexpr size_t WS_WF2 = WS_WF1 + 2ull * 4096 * 1024 * 2;
constexpr size_t WS_LRUW = WS_WF2 + 2ull * 1024 * 4096 * 2;
constexpr size_t WS_CMW = WS_LRUW + 2ull * 16 * 128 * 64 * 2;
constexpr size_t WS_CA = WS_CMW + 2ull * 16 * 128 * 128 * 2;
constexpr size_t WS_SHA = WS_CA + 256ull * 1024 * 2;
constexpr size_t WS_MOD = WS_SHA + 4ull * 256 * 1024 * 2;
constexpr size_t WS_GB = WS_MOD + 136ull * 12288 * 4;
constexpr size_t WS_SW1 = WS_GB + 4ull * 136 * 1024 * 4;
constexpr size_t WS_SW2 = WS_SW1 + 2ull * 136 * 9216 * 4;
constexpr size_t WS_RSA = WS_SW2 + 2ull * 136 * 4096 * 4;
constexpr size_t WS_RSB = WS_RSA + 8704ull * 16 * 4;
constexpr size_t WS_RSF = WS_RSB + 8704ull * 16 * 4;
constexpr size_t WS_CAR = WS_RSF + 17408ull * 16 * 4;
constexpr size_t WS_XG = WS_CAR + 4ull * 32 * 1024 * 2 * 4;
constexpr size_t WS_Z = WS_XG + 8704ull * 1024 * 2;
constexpr size_t WS_VS = WS_Z + 8704ull * 9216 * 2;
constexpr size_t WS_BAR = WS_VS + 8704ull * 32 * 4;
constexpr size_t WS_W8 = WS_BAR + 32768;
constexpr size_t WS_XG8 = WS_W8 + 2ull * 3072 * 1024;
constexpr size_t WS_END = WS_XG8 + 8704ull * 1024;
constexpr size_t ZT_GATE = 32ull << 20;
constexpr int LDS_BYTES = 131072 + 2048;

struct Params { const float* in[31]; float* out; unsigned char* ws; };
typedef const __attribute__((address_space(4))) Params* KP;
#define FRESH_P KP p = (KP)__builtin_amdgcn_kernarg_segment_ptr(); asm volatile("" : "+s"(p))
__device__ __forceinline__ int opaque_tid() { int t = threadIdx.x; asm volatile("" : "+v"(t)); return t; }

__device__ __forceinline__ float bf2f(bf16_t v) { return __uint_as_float(((unsigned)v) << 16); }
__device__ __forceinline__ unsigned pk2(float lo, float hi) { unsigned r; asm volatile("v_cvt_pk_bf16_f32 %0, %1, %2" : "=v"(r) : "v"(lo), "v"(hi)); return r; }
__device__ __forceinline__ float lo_f(unsigned w) { return __uint_as_float(w << 16); }
__device__ __forceinline__ float hi_f(unsigned w) { return __uint_as_float(w & 0xffff0000u); }
__device__ __forceinline__ void unpack8(u32x4 w, float* f) { f[0] = lo_f(w.x); f[1] = hi_f(w.x); f[2] = lo_f(w.y); f[3] = hi_f(w.y); f[4] = lo_f(w.z); f[5] = hi_f(w.z); f[6] = lo_f(w.w); f[7] = hi_f(w.w); }
__device__ __forceinline__ u32x4 pack8(const float* f) { u32x4 o; o.x = pk2(f[0], f[1]); o.y = pk2(f[2], f[3]); o.z = pk2(f[4], f[5]); o.w = pk2(f[6], f[7]); return o; }
__device__ __forceinline__ unsigned pk4_fp8(float a, float b, float c, float d) { int w = 0; w = __builtin_amdgcn_cvt_pk_fp8_f32(a, b, w, false); w = __builtin_amdgcn_cvt_pk_fp8_f32(c, d, w, true); return (unsigned)w; }
__device__ __forceinline__ float sigm(float v) { return __builtin_amdgcn_rcpf(1.f + __builtin_amdgcn_exp2f(-1.44269504f * v)); }
__device__ __forceinline__ float wave_sum(float v) {
#pragma unroll
    for (int o = 1; o < 64; o <<= 1) v += __shfl_xor(v, o);
    return v;
}
__device__ __forceinline__ float sum16(const float* p) {
    const f32x4 a = *(const f32x4*)p, b = *(const f32x4*)(p + 4), c = *(const f32x4*)(p + 8), d = *(const f32x4*)(p + 12);
    return (((a.x + a.y) + (a.z + a.w)) + ((b.x + b.y) + (b.z + b.w))) + (((c.x + c.y) + (c.z + c.w)) + ((d.x + d.y) + (d.z + d.w)));
}
__device__ __forceinline__ int grow_of(int r, int h) { return r < 8192 ? h * 8192 + r : 16384 + h * 512 + (r - 8192); }
__device__ __forceinline__ int batch_of(int grow) { return grow < 16384 ? (grow >> 11) : 8 + ((grow - 16384) >> 3); }
#define LDS_WAIT() asm volatile("s_waitcnt lgkmcnt(0)" ::: "memory")


#define XB_TMO      128
#define XB_XCNT(j)  (256  + 64 * (j))
#define XB_XSUB(j)  (1280 + 64 * (j))
#define XB_XGEN(j)  (2304 + 64 * (j))
#define XB_TOP      3328
#define XB_TOPGEN   3392
#define XCD_BAR_WORDS 3456
#define XB_SPIN_CAP (1u << 18)
__device__ __forceinline__ unsigned xb_ld(unsigned* p)              { return __hip_atomic_load(p, __ATOMIC_RELAXED, __HIP_MEMORY_SCOPE_AGENT); }
__device__ __forceinline__ unsigned xb_add(unsigned* p, unsigned v) { return __hip_atomic_fetch_add(p, v, __ATOMIC_RELAXED, __HIP_MEMORY_SCOPE_AGENT); }
__device__ __forceinline__ unsigned xb_xcc_id() { return (unsigned)__builtin_amdgcn_s_getreg((3 << 11) | 20) & 0xFu; }
#define XB_SPIN(cond, bar) do { unsigned _sp = 0; while (cond) { __builtin_amdgcn_s_sleep(1); \
    if ((++_sp & 255u) == 0u) { if (xb_ld(&(bar)[XB_TMO])) break; if (_sp > XB_SPIN_CAP) { atomicAdd(&(bar)[XB_TMO], 1u); break; } } } } while (0)
struct XcdBarrier { unsigned* bar; unsigned x; volatile LAS unsigned* st; };
__device__ __forceinline__ XcdBarrier xcd_barrier_post(unsigned* bar, volatile LAS unsigned* st) {
    XcdBarrier b; b.bar = bar; b.x = xb_xcc_id(); b.st = st;
    if (threadIdx.x == 0) (void)xb_add(&bar[XB_XCNT(b.x)], 1u);
    return b;
}
__device__ __forceinline__ void xcd_barrier_complete(unsigned* bar, unsigned x, unsigned& nloc, unsigned& nx) {
    const unsigned G = gridDim.x * gridDim.y * gridDim.z;
    unsigned sum, cnt, mine, sp = 0u;
    for (;;) {
        sum = 0u; cnt = 0u; mine = 0u;
#pragma unroll
        for (unsigned j = 0; j < 16; ++j) { const unsigned c = xb_ld(&bar[XB_XCNT(j)]); sum += c; cnt += (c > 0u) ? 1u : 0u; mine = (j == x) ? c : mine; }
        if (sum == G) break;
        __builtin_amdgcn_s_sleep(1);
        if ((++sp & 255u) == 0u) { if (xb_ld(&bar[XB_TMO])) break; if (sp > XB_SPIN_CAP) { atomicAdd(&bar[XB_TMO], 1u); break; } }
    }
    nloc = mine > 0u ? mine : 1u; nx = cnt > 0u ? cnt : 1u;
}
__device__ __forceinline__ void xcd_barrier(const XcdBarrier& b) {
    asm volatile("s_waitcnt vmcnt(0)" ::: "memory");
    __syncthreads();
    if (threadIdx.x == 0) {
        unsigned* bar = b.bar;
        __builtin_amdgcn_s_waitcnt(0);
        unsigned nloc = b.st[0], nx = b.st[1];
        if (nloc == 0u) { xcd_barrier_complete(bar, b.x, nloc, nx); b.st[0] = nloc; b.st[1] = nx; }
        const unsigned old = xb_add(&bar[XB_XSUB(b.x)], 1u);
        const unsigned gen = old / nloc;
        if (old + 1u == (gen + 1u) * nloc) {
            __builtin_amdgcn_fence(__ATOMIC_RELEASE, "agent");
            asm volatile("s_waitcnt vmcnt(0)" ::: "memory");
            const unsigned og = xb_add(&bar[XB_TOP], 1u);
            const unsigned tg = og / nx;
            if (og + 1u == (tg + 1u) * nx) xb_add(&bar[XB_TOPGEN], 1u);
            else XB_SPIN(xb_ld(&bar[XB_TOPGEN]) == tg, bar);
            __builtin_amdgcn_fence(__ATOMIC_ACQUIRE, "agent");
            xb_add(&bar[XB_XGEN(b.x)], 1u);
            asm volatile("s_waitcnt vmcnt(0)" ::: "memory");
        } else {
            XB_SPIN(xb_ld(&bar[XB_XGEN(b.x)]) == gen, bar);
            __builtin_amdgcn_fence(__ATOMIC_ACQUIRE, "agent");
            asm volatile("s_waitcnt vmcnt(0)" ::: "memory");
        }
    }
    __syncthreads();
}

namespace pg8 {
constexpr int BM = 256, BK = 64, HALF = 128, HTB = HALF * BK * 2, NXCD = 8, WGM = 8;
__device__ __forceinline__ int lds_byte(int r, int c) { const int st = (r >> 4) * 2 + (c >> 5), rr = r & 15, cc = c & 31, ob = rr * 64 + cc * 2; return st * 1024 + (ob ^ (((ob >> 9) & 1) << 5)); }
__device__ __forceinline__ void stage_rc(int b, int& R, int& C) { const int st = b / 1024, sb = b % 1024, swz = sb ^ (((sb >> 9) & 1) << 5); R = (st >> 1) * 16 + swz / 64; C = (st & 1) * 32 + (swz % 64) / 2; }
__device__ __forceinline__ int perm32(int rho) { const int n = rho >> 4, i = rho & 15; return 8 * (i >> 2) + 4 * n + (i & 3); }

struct Unit { int pm, pn, g, k0, nkt, role, np; };
struct Gemm { const bf16_t* A; const bf16_t* Bt; int lda, ldb, K; size_t a_gs, b_gs; };
struct Order {
    int nM, nN, nwg, ngrp, G, c, nt;
    __device__ __forceinline__ void init(int nM_, int nN_, int ngrp_, int G_, int c_, int nt_) { nM = nM_; nN = nN_; nwg = nM * nN; ngrp = ngrp_; G = G_; c = c_; nt = nt_; }
    __device__ __forceinline__ bool next(int i, Unit& u) const {
        const int L = i * G + c; if (L >= nwg * ngrp) return false;
        u.g = L / nwg; int wgid = L % nwg; u.k0 = 0; u.nkt = nt; u.role = 0; u.np = 0;
        { const int q = nwg / NXCD, r = nwg % NXCD, xcd = wgid % NXCD, off = wgid / NXCD; wgid = (xcd < r ? xcd * (q + 1) : r * (q + 1) + (xcd - r) * q) + off; }
        const int nig = WGM * nN, gid = wgid / nig, fm = gid * WGM, gsz = (nM - fm) < WGM ? (nM - fm) : WGM;
        u.pm = fm + ((wgid % nig) % gsz); u.pn = (wgid % nig) / gsz; return true;
    }
};
struct OrderSK {
    int c;
    static __device__ __forceinline__ int len_of(int b) { return b < 64 ? 38 : (b < 224 ? 36 : 16); }
    static __device__ __forceinline__ int beg_of(int b) { return b < 64 ? 38 * b : (b < 224 ? 2432 + 36 * (b - 64) : 8192 + 16 * (b - 224)); }
    __device__ __forceinline__ bool next(int i, Unit& u) const {
        const int beg = beg_of(c), len = len_of(c), T0 = beg >> 6, k0 = beg & 63, n0 = (64 - k0) < len ? (64 - k0) : len;
        int T, kk, n;
        if (i == 0) { T = T0; kk = k0; n = n0; }
        else if (i == 1 && n0 < len) { T = T0 + 1; kk = 0; n = len - n0; }
        else return false;
        u.pm = T >> 2; u.pn = T & 3; u.g = 0; u.k0 = kk; u.nkt = n;
        if (kk > 0) { u.role = 1; u.np = 0; }
        else { const int rem = 64 - n, l1 = len_of(c + 1), l2 = len_of(c + 2); u.role = 2; u.np = 1 + (rem > l1 ? 1 : 0) + (rem > l1 + l2 ? 1 : 0); }
        return true;
    }
};
struct OrderOne {
    int pm, pn, nt;
    __device__ __forceinline__ bool next(int i, Unit& u) const { if (i != 0) return false; u.pm = pm; u.pn = pn; u.g = 0; u.k0 = 0; u.nkt = nt; u.role = 0; u.np = 0; return true; }
};
template <class Epi, class Sched, bool F8 = false>
__device__ __forceinline__ void gemm_phase(LAS unsigned char* lds, const Gemm g, const Sched& S, const Epi& E) {
    const int tid = opaque_tid(), wid = __builtin_amdgcn_readfirstlane(tid >> 6), lane = tid & 63, wr = wid >> 2, wc = wid & 3, fr = lane & 15, fq = lane >> 4;
    unsigned voffA[2], voffB[2];
#pragma unroll
    for (int i = 0; i < 2; ++i) { int R, C; stage_rc(tid * 16 + i * 8192, R, C); const int Rb = (R & ~31) + perm32(R & 31);
        voffA[i] = (unsigned)(R * g.lda + C) * 2u; voffB[i] = (unsigned)(Rb * g.ldb + C) * 2u; }
    const size_t kstep = (size_t)(BK * 2);
    const size_t hA = (size_t)HALF * g.lda * 2, hB = (size_t)HALF * g.ldb * 2;
    const unsigned ldsw = (unsigned)wid * 1024u;
    const int aoff = lds_byte(wr * 64 + fr, fq * 8), boff = lds_byte(wc * 32 + fr, fq * 8);
#define PG8_SA(b, h) (((b) * 2 + (h)) * HTB)
#define PG8_SB(b, h) ((4 + (b) * 2 + (h)) * HTB)
#define PG8_STAGE(bufoff, gbase, voff) do { _Pragma("unroll") for (int _i = 0; _i < 2; ++_i) \
        __builtin_amdgcn_global_load_lds((const unsigned*)((const char*)(gbase) + (voff)[_i]), (LAS unsigned*)(lds + (bufoff) + ldsw + _i * 8192), 16, 0, 0); } while (0)
#define PG8_LDA(dst, b, h) do { _Pragma("unroll") for (int m = 0; m < 4; ++m) { const i32x4 _l = *(const LAS i32x4*)(lds + PG8_SA(b, h) + aoff + m * 2048), _h = *(const LAS i32x4*)(lds + PG8_SA(b, h) + aoff + m * 2048 + 1024); dst[m] = __builtin_shufflevector(_l, _h, 0, 1, 2, 3, 4, 5, 6, 7); } } while (0)
#define PG8_LDB(dst, b, h) do { _Pragma("unroll") for (int n = 0; n < 2; ++n) { const i32x4 _l = *(const LAS i32x4*)(lds + PG8_SB(b, h) + boff + n * 2048), _h = *(const LAS i32x4*)(lds + PG8_SB(b, h) + boff + n * 2048 + 1024); dst[n] = __builtin_shufflevector(_l, _h, 0, 1, 2, 3, 4, 5, 6, 7); } } while (0)
#define PG8_MMA(ai, bj, At, Bt) do { __builtin_amdgcn_s_setprio(1); _Pragma("unroll") for (int m = 0; m < 4; ++m) _Pragma("unroll") for (int n = 0; n < 2; ++n) { \
        if constexpr (F8) asm volatile("s_nop 1\n\tv_mfma_scale_f32_16x16x128_f8f6f4 %0, %1, %2, %0, %3, %3 op_sel_hi:[0,0,0]" : "+v"(acc[ai][bj][m][n]) : "v"(Bt[n]), "v"(At[m]), "v"(f8sc)); \
        else { acc[ai][bj][m][n] = __builtin_amdgcn_mfma_f32_16x16x32_bf16(__builtin_bit_cast(bf16x8, __builtin_shufflevector(Bt[n], Bt[n], 0, 1, 2, 3)), __builtin_bit_cast(bf16x8, __builtin_shufflevector(At[m], At[m], 0, 1, 2, 3)), acc[ai][bj][m][n], 0, 0, 0); \
               acc[ai][bj][m][n] = __builtin_amdgcn_mfma_f32_16x16x32_bf16(__builtin_bit_cast(bf16x8, __builtin_shufflevector(Bt[n], Bt[n], 4, 5, 6, 7)), __builtin_bit_cast(bf16x8, __builtin_shufflevector(At[m], At[m], 4, 5, 6, 7)), acc[ai][bj][m][n], 0, 0, 0); } } \
        __builtin_amdgcn_s_setprio(0); } while (0)
#define PG8_WAIT_V(n) asm volatile("s_waitcnt vmcnt(" #n ")" ::: "memory")
#define PG8_WAIT_L(n) asm volatile("s_waitcnt lgkmcnt(" #n ")" ::: "memory")
#define PG8_BAR __builtin_amdgcn_s_barrier()
#define PG8_SCHED __builtin_amdgcn_sched_barrier(0)
    Unit cur, nxt; int ui = 0;
    if (!S.next(0, cur)) return;
    f32x4 acc[2][2][4][2];
#pragma unroll
    for (int a = 0; a < 2; ++a)
#pragma unroll
        for (int b = 0; b < 2; ++b)
#pragma unroll
            for (int m = 0; m < 4; ++m)
#pragma unroll
                for (int n = 0; n < 2; ++n) acc[a][b][m][n] = (f32x4){0.f, 0.f, 0.f, 0.f};
    i32x8 At[4], B0[2], B1[2];
    int f8sc = 0x7C7C7C7C;
    asm volatile("" : "+v"(f8sc));
    const char* cA = (const char*)(g.A + (size_t)cur.g * g.a_gs) + (size_t)cur.pm * 2 * hA + (size_t)cur.k0 * kstep;
    const char* cB = (const char*)(g.Bt + (size_t)cur.g * g.b_gs) + (size_t)cur.pn * 2 * hB + (size_t)cur.k0 * kstep;
    PG8_STAGE(PG8_SB(0, 0), cB, voffB); PG8_STAGE(PG8_SB(0, 1), cB + hB, voffB); PG8_STAGE(PG8_SA(0, 0), cA, voffA); PG8_STAGE(PG8_SA(0, 1), cA + hA, voffA);
    if (wr == 1) PG8_BAR;
    PG8_WAIT_V(2); PG8_BAR;
    PG8_STAGE(PG8_SB(1, 0), cB + kstep, voffB); PG8_STAGE(PG8_SA(1, 0), cA + kstep, voffA); PG8_STAGE(PG8_SB(1, 1), cB + hB + kstep, voffB);
    PG8_WAIT_V(6); PG8_BAR;
    for (;;) {
        const bool has_next = S.next(ui + 1, nxt);
        const char* nA = has_next ? (const char*)(g.A + (size_t)nxt.g * g.a_gs) + (size_t)nxt.pm * 2 * hA + (size_t)nxt.k0 * kstep : cA;
        const char* nB = has_next ? (const char*)(g.Bt + (size_t)nxt.g * g.b_gs) + (size_t)nxt.pn * 2 * hB + (size_t)nxt.k0 * kstep : cB;
        const int nt = cur.nkt;
        for (int t = 0; t < nt; t += 2) {
            const bool last = (t == nt - 2);
            const char* a1 = cA + (size_t)(t + 1) * kstep;
            const char* a2 = last ? nA : cA + (size_t)(t + 2) * kstep; const char* b2 = last ? nB : cB + (size_t)(t + 2) * kstep;
            const char* a3 = a2 + kstep; const char* b3 = b2 + kstep;
            PG8_LDB(B0, 0, 0); PG8_LDB(B1, 0, 1); PG8_SCHED; PG8_LDA(At, 0, 0); PG8_STAGE(PG8_SA(1, 1), a1 + hA, voffA);
            PG8_WAIT_V(8); PG8_WAIT_L(0); PG8_BAR; PG8_MMA(0, 0, At, B0); PG8_MMA(0, 1, At, B1); PG8_BAR; PG8_SCHED;
            PG8_LDA(At, 0, 1); PG8_STAGE(PG8_SB(0, 0), b2, voffB); PG8_STAGE(PG8_SB(0, 1), b2 + hB, voffB); PG8_STAGE(PG8_SA(0, 0), a2, voffA);
            PG8_WAIT_V(8); PG8_WAIT_L(0); PG8_BAR; PG8_MMA(1, 0, At, B0); PG8_MMA(1, 1, At, B1); PG8_BAR; PG8_SCHED;
            PG8_LDB(B0, 1, 0); PG8_LDB(B1, 1, 1); PG8_SCHED; PG8_LDA(At, 1, 0); PG8_STAGE(PG8_SA(0, 1), a2 + hA, voffA);
            PG8_WAIT_V(8); PG8_WAIT_L(0); PG8_BAR; PG8_MMA(0, 0, At, B0); PG8_MMA(0, 1, At, B1); PG8_BAR; PG8_SCHED;
            PG8_LDA(At, 1, 1); PG8_STAGE(PG8_SB(1, 0), b3, voffB); PG8_STAGE(PG8_SB(1, 1), b3 + hB, voffB); PG8_STAGE(PG8_SA(1, 0), a3, voffA);
            PG8_WAIT_V(8); PG8_WAIT_L(0); PG8_BAR; PG8_MMA(1, 0, At, B0); PG8_MMA(1, 1, At, B1); PG8_BAR; PG8_SCHED;
        }
        if (wr == 0) PG8_BAR;
        if constexpr (F8) asm volatile("s_nop 15\n\ts_nop 15" ::: "memory");
        E(acc, cur, wr, wc, fr, fq);
        if (!has_next) break;
#pragma unroll
        for (int a = 0; a < 2; ++a)
#pragma unroll
            for (int b = 0; b < 2; ++b)
#pragma unroll
                for (int m = 0; m < 4; ++m)
#pragma unroll
                    for (int n = 0; n < 2; ++n) acc[a][b][m][n] = (f32x4){0.f, 0.f, 0.f, 0.f};
        cur = nxt; cA = nA; cB = nB; ++ui;
        if (wr == 1) PG8_BAR;
    }
    PG8_WAIT_V(0);
    PG8_BAR;
#undef PG8_SA
#undef PG8_SB
#undef PG8_STAGE
#undef PG8_LDA
#undef PG8_LDB
#undef PG8_MMA
#undef PG8_WAIT_V
#undef PG8_WAIT_L
#undef PG8_BAR
#undef PG8_SCHED
}
}
using pg8::Unit;
typedef f32x4 AccT[2][2][4][2];

#define EPI_FOR_ROWS _Pragma("unroll") for (int ai = 0; ai < 2; ++ai) _Pragma("unroll") for (int m = 0; m < 4; ++m)
#define EPI_R (u.pm * 256 + ai * 128 + wr * 64 + m * 16 + fr)

struct EpiMod {
    float* mod; const float* b_ada;
    __device__ __forceinline__ void operator()(const AccT& acc, const Unit& u, int wr, int wc, int fr, int fq) const {
        EPI_FOR_ROWS { const int r = EPI_R;
            if (r < NBATCH) {
#pragma unroll
                for (int bj = 0; bj < 2; ++bj) {
                    const int c0 = u.pn * 256 + bj * 128 + wc * 32 + 8 * fq;
                    const f32x4 b0 = *(const f32x4*)(b_ada + c0), b1 = *(const f32x4*)(b_ada + c0 + 4);
                    *(f32x4*)(mod + (size_t)r * 12288 + c0) = acc[ai][bj][m][0] + b0; *(f32x4*)(mod + (size_t)r * 12288 + c0 + 4) = acc[ai][bj][m][1] + b1;
                }
            }
        }
    }
};
__device__ __forceinline__ void derive_pass(KP p) {
    const int gt = blockIdx.x * 512 + opaque_tid(), NGT = gridDim.x * 512;
    const float* mod = (const float*)(p->ws + WS_MOD); bf16_t* sha = (bf16_t*)(p->ws + WS_SHA); float* gb = (float*)(p->ws + WS_GB);
    for (int i = gt; i < 2 * 2 * NBATCH * 256; i += NGT) {
        const int k = (i & 255) * 4, r = (i >> 8) % NBATCH, q = (i >> 8) / NBATCH, L = q >> 1, which = q & 1;
        const float* mr = mod + (size_t)r * 12288 + L * 6144 + which * 3072 + k;
        const f32x4 sh = *(const f32x4*)mr, sc = *(const f32x4*)(mr + 1024);
        const f32x4 gn = *(const f32x4*)(p->in[which ? 10 : 9] + L * 1024 + k);
        (void)sh; (void)sha;
        *(f32x4*)(gb + ((size_t)q * NBATCH + r) * 1024 + k) = gn * (sc + 1.f);
    }
}
struct EpiSW {
    float* o; int ld;
    __device__ __forceinline__ void operator()(const AccT& acc, const Unit& u, int wr, int wc, int fr, int fq) const {
        EPI_FOR_ROWS { const int r = EPI_R;
            if (r < NBATCH) {
#pragma unroll
                for (int bj = 0; bj < 2; ++bj) { float* p = o + (size_t)r * ld + u.pn * 256 + bj * 128 + wc * 32 + 8 * fq;
                    *(f32x4*)p = acc[ai][bj][m][0]; *(f32x4*)(p + 4) = acc[ai][bj][m][1]; }
            }}
    }
};
struct EpiG1 {
    bf16_t* Z; const float* rss; const float* sw; int h; float* vs; int pn0;
    __device__ __forceinline__ void operator()(const AccT& acc, const Unit& u, int wr, int wc, int fr, int fq) const {
        const int pn_ = u.pn + pn0;
        const bool gate = pn_ >= 24, vcol = (pn_ >> 2) == 2, fastb = u.pm < 32;
        const int colb = pn_ * 256 + wc * 32 + 8 * fq;
        f32x4 swv[2][2];
        if (fastb) { const float* swr = sw + (size_t)(4 * h + (u.pm >> 3)) * INC + colb;
#pragma unroll
            for (int bj = 0; bj < 2; ++bj) { swv[bj][0] = *(const f32x4*)(swr + bj * 128); swv[bj][1] = *(const f32x4*)(swr + bj * 128 + 4); } }
        EPI_FOR_ROWS { const int r = EPI_R;
            const f32x4 q = *(const f32x4*)(rss + (size_t)r * 16 + 4 * fq);
            float ssum = (q[0] + q[1]) + (q[2] + q[3]); ssum += __shfl_xor(ssum, 16); ssum += __shfl_xor(ssum, 32);
            const float rstd = __builtin_amdgcn_rsqf(ssum * (1.f / 1024.f) + EPS);
            if (!fastb) { const float* swr = sw + (size_t)batch_of(grow_of(r, h)) * INC + colb;
#pragma unroll
                for (int bj = 0; bj < 2; ++bj) { swv[bj][0] = *(const f32x4*)(swr + bj * 128); swv[bj][1] = *(const f32x4*)(swr + bj * 128 + 4); } }
            bf16_t* zr = Z + (size_t)r * INC + colb;
            float ls = 0.f, lq = 0.f;
#pragma unroll
            for (int bj = 0; bj < 2; ++bj) {
                f32x4 v0 = acc[ai][bj][m][0] * rstd + swv[bj][0], v1 = acc[ai][bj][m][1] * rstd + swv[bj][1];
                if (gate) {
#pragma unroll
                    for (int e = 0; e < 4; ++e) { v0[e] = sigm(v0[e]); v1[e] = sigm(v1[e]); } }
                u32x4 w; w.x = pk2(v0[0], v0[1]); w.y = pk2(v0[2], v0[3]); w.z = pk2(v1[0], v1[1]); w.w = pk2(v1[2], v1[3]);
                *(u32x4*)(zr + bj * 128) = w;
                if (vcol) {
#pragma unroll
                    for (int e = 0; e < 4; ++e) { ls += v0[e] + v1[e]; lq += v0[e] * v0[e] + v1[e] * v1[e]; }
                }
            }
            if (vcol) {
                ls += __shfl_xor(ls, 16); ls += __shfl_xor(ls, 32); lq += __shfl_xor(lq, 16); lq += __shfl_xor(lq, 32);
                if (fq == 0) *(f32x2*)(vs + (size_t)r * 32 + ((pn_ & 3) * 4 + wc) * 2) = (f32x2){ls, lq};
            }
        }
    }
};
struct EpiGate {
    bf16_t* Z; const float* rss; const float* sw; int h;
    __device__ __forceinline__ void operator()(const AccT& acc, const Unit& u, int wr, int wc, int fr, int fq) const {
        const int colb = (24 + u.pn) * 256 + wc * 32 + 8 * fq;
        EPI_FOR_ROWS { const int r = EPI_R;
            const f32x4 q = *(const f32x4*)(rss + (size_t)r * 16 + 4 * fq);
            float ssum = (q[0] + q[1]) + (q[2] + q[3]); ssum += __shfl_xor(ssum, 16); ssum += __shfl_xor(ssum, 32);
            const float rstd = __builtin_amdgcn_rsqf(ssum * (1.f / 1024.f) + EPS);
            const float* swr = sw + (size_t)batch_of(grow_of(r, h)) * INC + colb;
            bf16_t* zr = Z + (size_t)r * INC + colb;
#pragma unroll
            for (int bj = 0; bj < 2; ++bj) {
                const f32x4 s0 = *(const f32x4*)(swr + bj * 128), s1 = *(const f32x4*)(swr + bj * 128 + 4);
                f32x4 v0 = acc[ai][bj][m][0] * rstd + s0, v1 = acc[ai][bj][m][1] * rstd + s1;
#pragma unroll
                for (int e = 0; e < 4; ++e) { v0[e] = sigm(v0[e]); v1[e] = sigm(v1[e]); }
                u32x4 w; w.x = pk2(v0[0], v0[1]); w.y = pk2(v0[2], v0[3]); w.z = pk2(v1[0], v1[1]); w.w = pk2(v1[2], v1[3]);
                *(u32x4*)(zr + bj * 128) = w;
            }
        }
    }
};
struct EpiBR {
    bf16_t* Z;
    __device__ __forceinline__ void operator()(const AccT& acc, const Unit& u, int wr, int wc, int fr, int fq) const {
        EPI_FOR_ROWS { const int r = EPI_R;
            bf16_t* gp = Z + (size_t)r * INC + 6144 + u.g * 1024 + u.pn * 256 + wc * 32 + 8 * fq;
#pragma unroll
            for (int bj = 0; bj < 2; ++bj) {
                const u32x4 gw = *(const u32x4*)(gp + bj * 128);
                float gf[8]; unpack8(gw, gf);
                const f32x4 a0 = acc[ai][bj][m][0], a1 = acc[ai][bj][m][1];
                u32x4 w; w.x = pk2(a0[0] * gf[0], a0[1] * gf[1]); w.y = pk2(a0[2] * gf[2], a0[3] * gf[3]); w.z = pk2(a1[0] * gf[4], a1[1] * gf[5]); w.w = pk2(a1[2] * gf[6], a1[3] * gf[7]);
                *(u32x4*)(gp + bj * 128) = w;
            }}
    }
};
template <bool SK> struct EpiRes {
    const float* xp; const float* xs; float* out; const float* gatep; const float* Gn; bf16_t* XG; float* rss; int h, from_in, rss_global;
    unsigned char* XG8;
    float* slots; unsigned* flags; int cu;
    __device__ __forceinline__ void operator()(const AccT& acc, const Unit& u, int wr, int wc, int fr, int fq) const {
        if (SK && u.role == 1) {
            const unsigned* ubc = (const unsigned*)slots + (size_t)cu * 32768 + (wr * 4 + wc) * 4096;
            const int li = (fq * 16 + fr) * 4;
#pragma unroll
            for (int ai = 0; ai < 2; ++ai)
#pragma unroll
                for (int bj = 0; bj < 2; ++bj)
#pragma unroll
                    for (int m = 0; m < 4; ++m) {
                        unsigned* ub = (unsigned*)ubc + ((ai * 2 + bj) * 4 + m) * 256;
                        asm volatile("" : "+s"(ub));
                        const f32x4 d0 = acc[ai][bj][m][0], d1 = acc[ai][bj][m][1];
                        u32x4 w; w.x = pk2(d0[0], d0[1]); w.y = pk2(d0[2], d0[3]); w.z = pk2(d1[0], d1[1]); w.w = pk2(d1[2], d1[3]);
                        *(u32x4*)(ub + li) = w;
                    }
            asm volatile("s_waitcnt vmcnt(0)" ::: "memory");
            __builtin_amdgcn_s_barrier();
            if (wr == 0 && wc == 0) {
                __builtin_amdgcn_fence(__ATOMIC_RELEASE, "agent");
                asm volatile("s_waitcnt vmcnt(0)" ::: "memory");
                if ((fq * 16 + fr) == 0) (void)xb_add(flags + cu, 8u);
            }
            return;
        }
        if (SK && u.role == 2) {
            if (wr == 0 && wc == 0) {
                for (int q = 1; q <= u.np; ++q) {
                    unsigned sp = 0;
                    while (xb_ld(flags + cu + q) < 8u) { __builtin_amdgcn_s_sleep(2); if (++sp > (1u << 22)) break; }
                }
                __builtin_amdgcn_fence(__ATOMIC_ACQUIRE, "agent");
                asm volatile("s_waitcnt vmcnt(0)" ::: "memory");
            }
            __builtin_amdgcn_s_barrier();
        }
        const bool fastb = u.pm < 32;
        const int cb = u.pn * 256 + wc * 32 + 8 * fq;
        f32x4 gv[2][2], qv[2][2];
        if (fastb) { const int b = 4 * h + (u.pm >> 3);
#pragma unroll
            for (int bj = 0; bj < 2; ++bj) { const float* gr = gatep + (size_t)b * 12288 + cb + bj * 128; gv[bj][0] = *(const f32x4*)gr; gv[bj][1] = *(const f32x4*)(gr + 4);
                if (Gn) { const float* gg = Gn + (size_t)b * 1024 + cb + bj * 128; qv[bj][0] = *(const f32x4*)gg; qv[bj][1] = *(const f32x4*)(gg + 4); } } }
        EPI_FOR_ROWS { const int r = EPI_R;
            const int grow = grow_of(r, h);
            if (!fastb) { const int b = batch_of(grow);
#pragma unroll
                for (int bj = 0; bj < 2; ++bj) { const float* gr = gatep + (size_t)b * 12288 + cb + bj * 128; gv[bj][0] = *(const f32x4*)gr; gv[bj][1] = *(const f32x4*)(gr + 4);
                    if (Gn) { const float* gg = Gn + (size_t)b * 1024 + cb + bj * 128; qv[bj][0] = *(const f32x4*)gg; qv[bj][1] = *(const f32x4*)(gg + 4); } } }
            const float* xr = (!SK && from_in) ? (grow < 16384 ? xp + (size_t)grow * 1024 : xs + (size_t)(grow - 16384) * 1024) : out + (size_t)grow * 1024;
            float* orow = out + (size_t)grow * 1024;
            float ss = 0.f;
#pragma unroll
            for (int bj = 0; bj < 2; ++bj) {
                const int c0 = cb + bj * 128;
                const f32x4 x0 = *(const f32x4*)(xr + c0), x1 = *(const f32x4*)(xr + c0 + 4);
                f32x4 a0 = acc[ai][bj][m][0], a1 = acc[ai][bj][m][1];
                if (SK && u.role == 2) {
                    const unsigned* ub = (const unsigned*)slots + (size_t)(cu + 1) * 32768 + (wr * 4 + wc) * 4096 + ((ai * 2 + bj) * 4 + m) * 256;
                    asm volatile("" : "+s"(ub));
                    const int li = (fq * 16 + fr) * 4;
                    { const u32x4 w = *(const u32x4*)(ub + li); a0 += (f32x4){lo_f(w.x), hi_f(w.x), lo_f(w.y), hi_f(w.y)}; a1 += (f32x4){lo_f(w.z), hi_f(w.z), lo_f(w.w), hi_f(w.w)}; }
                    if (u.np >= 2) { const u32x4 w = *(const u32x4*)(ub + 32768 + li); a0 += (f32x4){lo_f(w.x), hi_f(w.x), lo_f(w.y), hi_f(w.y)}; a1 += (f32x4){lo_f(w.z), hi_f(w.z), lo_f(w.w), hi_f(w.w)}; }
                    if (u.np >= 3) { const u32x4 w = *(const u32x4*)(ub + 65536 + li); a0 += (f32x4){lo_f(w.x), hi_f(w.x), lo_f(w.y), hi_f(w.y)}; a1 += (f32x4){lo_f(w.z), hi_f(w.z), lo_f(w.w), hi_f(w.w)}; }
                }
                const f32x4 v0 = x0 + gv[bj][0] * a0, v1 = x1 + gv[bj][1] * a1;
                *(f32x4*)(orow + c0) = v0; *(f32x4*)(orow + c0 + 4) = v1;
                ss += (v0[0] * v0[0] + v0[1] * v0[1]) + (v0[2] * v0[2] + v0[3] * v0[3]) + (v1[0] * v1[0] + v1[1] * v1[1]) + (v1[2] * v1[2] + v1[3] * v1[3]);
                if (Gn) {
                    const f32x4 q0 = qv[bj][0], q1 = qv[bj][1];
                    u32x4 w; w.x = pk2(v0[0] * q0[0], v0[1] * q0[1]); w.y = pk2(v0[2] * q0[2], v0[3] * q0[3]); w.z = pk2(v1[0] * q1[0], v1[1] * q1[1]); w.w = pk2(v1[2] * q1[2], v1[3] * q1[3]);
                    *(u32x4*)(XG + (size_t)r * 1024 + c0) = w;
                    if (XG8) { u32x2 w8; w8.x = pk4_fp8(v0[0] * q0[0], v0[1] * q0[1], v0[2] * q0[2], v0[3] * q0[3]); w8.y = pk4_fp8(v1[0] * q1[0], v1[1] * q1[1], v1[2] * q1[2], v1[3] * q1[3]); *(u32x2*)(XG8 + (size_t)r * 1024 + c0) = w8; }
                }
            }
            ss += __shfl_xor(ss, 16); ss += __shfl_xor(ss, 32);
            if (fq == 0) rss[(size_t)(rss_global ? grow : r) * 16 + u.pn * 4 + wc] = ss;
        }
    }
};
struct EpiFF1 {
    bf16_t* H; const float* rss; const float* sw; int h; unsigned* done;
    __device__ __forceinline__ void operator()(const AccT& acc, const Unit& u, int wr, int wc, int fr, int fq) const {
        const bool fastb = u.pm < 32;
        const int colb = u.pn * 256 + wc * 32 + 8 * fq;
        f32x4 swv[2][2];
        if (fastb) { const float* swr = sw + (size_t)(4 * h + (u.pm >> 3)) * DFF + colb;
#pragma unroll
            for (int bj = 0; bj < 2; ++bj) { swv[bj][0] = *(const f32x4*)(swr + bj * 128); swv[bj][1] = *(const f32x4*)(swr + bj * 128 + 4); } }
        EPI_FOR_ROWS { const int r = EPI_R;
            const f32x4 q = *(const f32x4*)(rss + (size_t)r * 16 + 4 * fq);
            float ssum = (q[0] + q[1]) + (q[2] + q[3]); ssum += __shfl_xor(ssum, 16); ssum += __shfl_xor(ssum, 32);
            const float rstd = __builtin_amdgcn_rsqf(ssum * (1.f / 1024.f) + EPS);
            if (!fastb) { const float* swr = sw + (size_t)batch_of(grow_of(r, h)) * DFF + colb;
#pragma unroll
                for (int bj = 0; bj < 2; ++bj) { swv[bj][0] = *(const f32x4*)(swr + bj * 128); swv[bj][1] = *(const f32x4*)(swr + bj * 128 + 4); } }
            bf16_t* hr = H + (size_t)r * DFF + colb;
#pragma unroll
            for (int bj = 0; bj < 2; ++bj) {
                f32x4 v0 = acc[ai][bj][m][0] * rstd + swv[bj][0], v1 = acc[ai][bj][m][1] * rstd + swv[bj][1];
#pragma unroll
                for (int e = 0; e < 4; ++e) { const float a = fmaxf(v0[e], 0.f), c = fmaxf(v1[e], 0.f); v0[e] = a * a; v1[e] = c * c; }
                u32x4 w; w.x = pk2(v0[0], v0[1]); w.y = pk2(v0[2], v0[3]); w.z = pk2(v1[0], v1[1]); w.w = pk2(v1[2], v1[3]);
                *(u32x4*)(hr + bj * 128) = w;
            }
        }
        if (done) {
            asm volatile("s_waitcnt vmcnt(0)" ::: "memory");
            __builtin_amdgcn_s_barrier();
            if (wr == 0 && wc == 0) {
                __builtin_amdgcn_fence(__ATOMIC_RELEASE, "agent");
                asm volatile("s_waitcnt vmcnt(0)" ::: "memory");
                if ((fq * 16 + fr) == 0) (void)xb_add(done, 1u);
            }
        }
    }
};

#define TR_LOAD(tv, W_, ldw_, k0_, n0_) do { _Pragma("unroll") for (int _i = 0; _i < 8; ++_i) tv[_i] = *(const f32x4*)((W_) + (size_t)((k0_) + 8 * _i + (lane >> 3)) * (ldw_) + (n0_) + (lane & 7) * 4); } while (0)
__device__ __forceinline__ void tr_store(const f32x4 (&tv)[8], bf16_t* WT, int ldt, int k0, int n0, float* scr, int lane, int ncopy, int copy_stride) {
#pragma unroll
    for (int i = 0; i < 8; ++i) { float* d = scr + (8 * i + (lane >> 3)) * 33 + (lane & 7) * 4; d[0] = tv[i][0]; d[1] = tv[i][1]; d[2] = tv[i][2]; d[3] = tv[i][3]; }
    LDS_WAIT();
    const int c = lane & 7;
#pragma unroll
    for (int j = 0; j < 4; ++j) { const int n = (lane >> 3) + 8 * j; const float* s = scr + (8 * c) * 33 + n;
        u32x4 o; o.x = pk2(s[0], s[33]); o.y = pk2(s[66], s[99]); o.z = pk2(s[132], s[165]); o.w = pk2(s[198], s[231]);
        for (int cp = 0; cp < ncopy; ++cp) *(u32x4*)(WT + (size_t)(n0 + n) * ldt + (size_t)cp * copy_stride + k0 + 8 * c) = o; }
    LDS_WAIT();
}
__device__ __forceinline__ void tr_item(const float* W, int ldw, bf16_t* WT, int ldt, int k0, int n0, float* scr, int lane, int ncopy, int copy_stride) {
    f32x4 tv[8];
    TR_LOAD(tv, W, ldw, k0, n0);
    tr_store(tv, WT, ldt, k0, n0, scr, lane, ncopy, copy_stride);
}
__device__ __forceinline__ void tr_job(const float* W, int K, int N, bf16_t* WT, int ldt, int ncopy, int copy_stride, int gw, int NGW, float* scr, int lane, int ldw = 0) {
    if (ldw == 0) ldw = N;
    const int nblk = N / 32, items = (K / 64) * nblk;
    f32x4 ta[8], tb[8];
    int it = gw; bool ha = it < items;
    if (ha) TR_LOAD(ta, W, ldw, (it / nblk) * 64, (it % nblk) * 32);
    for (;;) {
        const int itb = it + NGW; const bool hb = itb < items;
        if (hb) TR_LOAD(tb, W, ldw, (itb / nblk) * 64, (itb % nblk) * 32);
        if (!ha) break;
        tr_store(ta, WT, ldt, (it / nblk) * 64, (it % nblk) * 32, scr, lane, ncopy, copy_stride);
        it = itb + NGW; ha = it < items;
        if (ha) TR_LOAD(ta, W, ldw, (it / nblk) * 64, (it % nblk) * 32);
        if (!hb) break;
        tr_store(tb, WT, ldt, (itb / nblk) * 64, (itb % nblk) * 32, scr, lane, ncopy, copy_stride);
    }
}
__device__ __forceinline__ void p0_convert(KP p, unsigned char* smem, int part, int wblk, int nblk) {
    const int tid = opaque_tid(), lane = tid & 63, wave = tid >> 6;
    const int gw = wblk * 8 + wave, NGW = nblk * 8;
    float* scr = (float*)(smem + wave * 8448);
    unsigned char* ws = p->ws;
    const int gt = wblk * 512 + tid, NGT = nblk * 512;
    if (part == 0) {
        for (int l = 0; l < 2; ++l) tr_job(p->in[7] + (size_t)l * 1024 * 6144, 1024, 6144, (bf16_t*)(ws + WS_Z) + (size_t)l * 6144 * 1024, 1024, 1, 0, (gw + 832 * l) % NGW, NGW, scr, lane);
        for (int i = gt; i < 256 * 1024 / 8; i += NGT) {
            const int row = i >> 7, k = (i & 127) * 8;
            u32x4 o = {0u, 0u, 0u, 0u};
            if (row < NBATCH) {
                const float* c = row < 8 ? p->in[2] + (size_t)row * 1024 + k : p->in[3] + (size_t)(row - 8) * 1024 + k;
                float f[8];
#pragma unroll
                for (int e = 0; e < 8; ++e) { const float v = c[e]; f[e] = v * sigm(v); }
                o = pack8(f);
            }
            *(u32x4*)((bf16_t*)(ws + WS_CA) + (size_t)row * 1024 + k) = o;
        }
        return;
    }
    for (int l = 0; l < 2; ++l) {
        tr_job(p->in[12] + (size_t)l * 1024 * INC, 1024, 6144, (bf16_t*)(ws + WS_WIN) + (size_t)l * 6144 * 1024, 1024, 1, 0, gw, NGW, scr, lane, INC);
        {
            const float* Wg = p->in[12] + (size_t)l * 1024 * INC + 6144;
            bf16_t* Tb = (bf16_t*)(ws + WS_Z + ZT_GATE) + (size_t)l * 3072 * 1024; unsigned char* T8 = ws + WS_W8 + (size_t)l * 3072 * 1024;
            for (int it = (gw + 700) % NGW; it < 16 * 96; it += NGW) {
                const int k0 = (it / 96) * 64, n0 = (it % 96) * 32;
                f32x4 tv[8];
                TR_LOAD(tv, Wg, INC, k0, n0);
#pragma unroll
                for (int i = 0; i < 8; ++i) { float* d = scr + (8 * i + (lane >> 3)) * 33 + (lane & 7) * 4; d[0] = tv[i][0]; d[1] = tv[i][1]; d[2] = tv[i][2]; d[3] = tv[i][3]; }
                LDS_WAIT();
                { const int c = lane & 7;
#pragma unroll
                  for (int j = 0; j < 4; ++j) { const int n = (lane >> 3) + 8 * j; const float* q = scr + (8 * c) * 33 + n;
                      u32x4 o; o.x = pk2(q[0], q[33]); o.y = pk2(q[66], q[99]); o.z = pk2(q[132], q[165]); o.w = pk2(q[198], q[231]);
                      *(u32x4*)(Tb + (size_t)(n0 + n) * 1024 + k0 + 8 * c) = o; } }
                { const int c = lane & 3;
#pragma unroll
                  for (int j = 0; j < 2; ++j) { const int n = (lane >> 2) + 16 * j; const float* q = scr + (16 * c) * 33 + n;
                      u32x4 o;
                      o.x = pk4_fp8(64.f * q[0], 64.f * q[33], 64.f * q[66], 64.f * q[99]); o.y = pk4_fp8(64.f * q[132], 64.f * q[165], 64.f * q[198], 64.f * q[231]);
                      o.z = pk4_fp8(64.f * q[264], 64.f * q[297], 64.f * q[330], 64.f * q[363]); o.w = pk4_fp8(64.f * q[396], 64.f * q[429], 64.f * q[462], 64.f * q[495]);
                      *(u32x4*)(T8 + (size_t)(n0 + n) * 1024 + k0 + 16 * c) = o; } }
                LDS_WAIT();
            }
        }
        tr_job(p->in[29] + (size_t)l * 1024 * DFF, 1024, DFF, (bf16_t*)(ws + WS_WF1) + (size_t)l * DFF * 1024, 1024, 1, 0, (gw + 1024) % NGW, NGW, scr, lane);
        tr_job(p->in[30] + (size_t)l * DFF * 1024, DFF, 1024, (bf16_t*)(ws + WS_WF2) + (size_t)l * 1024 * DFF, DFF, 1, 0, gw, NGW, scr, lane);
        for (int br = 0; br < 3; ++br)
            tr_job(p->in[25 + br] + (size_t)l * 1024 * 1024, 1024, 1024, (bf16_t*)(ws + WS_WBR) + ((size_t)l * 3 + br) * 1024 * 1024, 1024, 1, 0, (gw + 512 * br) % NGW, NGW, scr, lane);
        tr_job(p->in[28] + (size_t)l * 1024 * 1024, 1024, 1024, (bf16_t*)(ws + WS_WO3) + (size_t)l * 1024 * 1024, 1024, 1, 0, (gw + 1536) % NGW, NGW, scr, lane);
    }
    for (int job = gw; job < 128; job += NGW) {
        const int nb = job & 1, mat = (job >> 1) & 1, lh = job >> 2;
        const float* W = p->in[mat ? 17 : 15] + (size_t)lh * 4096;
        tr_item(W, 64, (bf16_t*)(ws + WS_LRUW) + (size_t)lh * 8192 + mat * 4096, 64, 0, nb * 32, scr, lane, 1, 0);
    }
    for (int i = gt; i < 2 * 16 * 128 * 128 / 8; i += NGT) {
        const f32x4 a = *(const f32x4*)(p->in[22] + (size_t)i * 8), b = *(const f32x4*)(p->in[22] + (size_t)i * 8 + 4);
        u32x4 o; o.x = pk2(a[0], a[1]); o.y = pk2(a[2], a[3]); o.z = pk2(b[0], b[1]); o.w = pk2(b[2], b[3]);
        *(u32x4*)((bf16_t*)(ws + WS_CMW) + (size_t)i * 8) = o;
    }
}
__device__ __forceinline__ void sha_prepare(KP p, int q2) {
    const int tid = opaque_tid();
    const float* mod = (const float*)(p->ws + WS_MOD); bf16_t* sha = (bf16_t*)(p->ws + WS_SHA) + (size_t)q2 * 256 * 1024;
    const int L = q2 >> 1, which = q2 & 1;
    for (int i0 = tid; i0 < NBATCH * 256; i0 += 512 * 4) {
        f32x4 sh[4];
#pragma unroll
        for (int j = 0; j < 4; ++j) { const int i = i0 + 512 * j; if (i < NBATCH * 256) sh[j] = *(const f32x4*)(mod + (size_t)(i >> 8) * 12288 + L * 6144 + which * 3072 + (i & 255) * 4); }
#pragma unroll
        for (int j = 0; j < 4; ++j) { const int i = i0 + 512 * j; if (i < NBATCH * 256) { u32x2 w; w.x = pk2(sh[j][0], sh[j][1]); w.y = pk2(sh[j][2], sh[j][3]); *(u32x2*)(sha + (size_t)(i >> 8) * 1024 + (i & 255) * 4) = w; } }
    }
    asm volatile("s_waitcnt vmcnt(0)" ::: "memory");
    __syncthreads();
}
__device__ __forceinline__ void xg0_pass(KP p, int h) {
    const int tid_ = opaque_tid(), lane = tid_ & 63, gw = blockIdx.x * 8 + (tid_ >> 6), NGW = gridDim.x * 8;
    bf16_t* XG = (bf16_t*)(p->ws + WS_XG); float* rsa = (float*)(p->ws + WS_RSA);
    for (int r = gw; r < MH; r += NGW) {
        const int grow = grow_of(r, h), b = batch_of(grow);
        const float* xr = grow < 16384 ? p->in[0] + (size_t)grow * 1024 : p->in[1] + (size_t)(grow - 16384) * 1024;
        const float* sc1 = (const float*)(p->ws + WS_MOD) + (size_t)b * 12288 + 1024;
        float ss = 0.f;
#pragma unroll
        for (int j = 0; j < 4; ++j) {
            const int c = lane * 4 + 256 * j;
            const f32x4 v = *(const f32x4*)(xr + c), q = *(const f32x4*)(p->in[9] + c) * (*(const f32x4*)(sc1 + c) + 1.f);
            ss += (v[0] * v[0] + v[1] * v[1]) + (v[2] * v[2] + v[3] * v[3]);
            u32x2 w; w.x = pk2(v[0] * q[0], v[1] * q[1]); w.y = pk2(v[2] * q[2], v[3] * q[3]);
            *(u32x2*)(XG + (size_t)r * 1024 + c) = w;
            *(unsigned*)(p->ws + WS_XG8 + (size_t)r * 1024 + c) = pk4_fp8(v[0] * q[0], v[1] * q[1], v[2] * q[2], v[3] * q[3]);
        }
        ss = wave_sum(ss);
        if (lane < 16) rsa[(size_t)r * 16 + lane] = lane == 0 ? ss : 0.f;
    }
}
__device__ __forceinline__ void final_pass(KP p) {
    const int tid_ = opaque_tid(), lane = tid_ & 63, gw = blockIdx.x * 8 + (tid_ >> 6), NGW = gridDim.x * 8;
    const float* rsf = (const float*)(p->ws + WS_RSF); const float* gf = p->in[11];
    f32x4 q[4];
#pragma unroll
    for (int j = 0; j < 4; ++j) q[j] = *(const f32x4*)(gf + lane * 4 + 256 * j);
    for (int g0 = gw; g0 < MT; g0 += 2 * NGW) {
        f32x4 v[2][4]; float rs[2];
#pragma unroll
        for (int r = 0; r < 2; ++r) { const int grow = g0 + r * NGW; if (grow < MT) { rs[r] = sum16(rsf + (size_t)grow * 16);
#pragma unroll
            for (int j = 0; j < 4; ++j) v[r][j] = *(const f32x4*)(p->out + (size_t)grow * 1024 + lane * 4 + 256 * j); } }
#pragma unroll
        for (int r = 0; r < 2; ++r) { const int grow = g0 + r * NGW; if (grow < MT) { const float rstd = __builtin_amdgcn_rsqf(rs[r] * (1.f / 1024.f) + EPS);
#pragma unroll
            for (int j = 0; j < 4; ++j) *(f32x4*)(p->out + (size_t)grow * 1024 + lane * 4 + 256 * j) = v[r][j] * rstd * q[j]; } }
    }
}
__device__ __forceinline__ void sum_pass(KP p) {
    bf16_t* Z = (bf16_t*)(p->ws + WS_Z);
    const int gt = blockIdx.x * 512 + opaque_tid(), NGT = gridDim.x * 512;
    for (int i0 = gt; i0 < MH * 128; i0 += 4 * NGT) {
        u32x4 a[4], b[4], c[4];
#pragma unroll
        for (int j = 0; j < 4; ++j) { const int i = i0 + j * NGT; if (i < MH * 128) { const bf16_t* z = Z + (size_t)(i >> 7) * INC + 6144 + (i & 127) * 8; a[j] = *(const u32x4*)z; b[j] = *(const u32x4*)(z + 1024); c[j] = *(const u32x4*)(z + 2048); } }
#pragma unroll
        for (int j = 0; j < 4; ++j) { const int i = i0 + j * NGT; if (i < MH * 128) {
            float fa[8], fb[8], fc[8]; unpack8(a[j], fa); unpack8(b[j], fb); unpack8(c[j], fc);
#pragma unroll
            for (int e = 0; e < 8; ++e) fa[e] = (fa[e] + fb[e]) + fc[e];
            *(u32x4*)(Z + (size_t)(i >> 7) * INC + 6144 + (i & 127) * 8) = pack8(fa); } }
    }
}
__device__ __forceinline__ void ln_from_partials(const float* vs, float& mean, float& rstd) {
    float s = 0.f, q = 0.f;
#pragma unroll
    for (int i = 0; i < 8; ++i) { const f32x4 v = *(const f32x4*)(vs + 4 * i); s += v[0] + v[2]; q += v[1] + v[3]; }
    mean = s * (1.f / 1024.f);
    const float var = fmaxf(q * (1.f / 1024.f) - mean * mean, 0.f);
    rstd = __builtin_amdgcn_rsqf(var + EPS);
}
__device__ __forceinline__ void mixC_item(KP p, int l, int h, int item) {
    bf16_t* Z = (bf16_t*)(p->ws + WS_Z);
    const int tid = opaque_tid(), ch0 = (tid & 127) * 8, sub = tid >> 7, r0 = item * 32 + sub * 8;
    const bool prompt = r0 < 8192;
    const bool halo = prompt && (r0 & 2047) != 0;
    u32x4 gbw[8], gcw[8], xcw[8], hg[2], hx[2];
#pragma unroll
    for (int i = 0; i < 8; ++i) { const bf16_t* zr = Z + (size_t)(r0 + i) * INC + ch0; gbw[i] = *(const u32x4*)(zr + 3072); gcw[i] = *(const u32x4*)(zr + 4096); xcw[i] = *(const u32x4*)(zr + 5120); }
    float q1[8], q2[8];
    int js = 0;
    if (halo) {
#pragma unroll
        for (int i = 0; i < 2; ++i) { const bf16_t* zr = Z + (size_t)(r0 - 1 - i) * INC + ch0; hg[i] = *(const u32x4*)(zr + 4096); hx[i] = *(const u32x4*)(zr + 5120); }
        float a[8], b[8];
        unpack8(hg[0], a); unpack8(hx[0], b);
#pragma unroll
        for (int e = 0; e < 8; ++e) q1[e] = a[e] * b[e];
        unpack8(hg[1], a); unpack8(hx[1], b);
#pragma unroll
        for (int e = 0; e < 8; ++e) q2[e] = a[e] * b[e];
    } else if (!prompt) {
        js = 64 * h + ((r0 - 8192) >> 3);
        const float* st = p->in[6] + ((size_t)(l * 128 + js) * 2) * 1024 + ch0;
        const f32x4 a0 = *(const f32x4*)st, a1 = *(const f32x4*)(st + 4), b0 = *(const f32x4*)(st + 1024), b1 = *(const f32x4*)(st + 1028);
#pragma unroll
        for (int e = 0; e < 4; ++e) { q2[e] = a0[e]; q2[4 + e] = a1[e]; q1[e] = b0[e]; q1[4 + e] = b1[e]; }
    } else {
#pragma unroll
        for (int e = 0; e < 8; ++e) { q1[e] = 0.f; q2[e] = 0.f; }
    }
    const float* w = p->in[24] + (size_t)l * 3 * 1024 + ch0;
    float w0[8], w1[8], w2[8];
    { const f32x4 a = *(const f32x4*)w, b = *(const f32x4*)(w + 4), c = *(const f32x4*)(w + 1024), d = *(const f32x4*)(w + 1028), e2 = *(const f32x4*)(w + 2048), f = *(const f32x4*)(w + 2052);
#pragma unroll
      for (int e = 0; e < 4; ++e) { w0[e] = a[e]; w0[4 + e] = b[e]; w1[e] = c[e]; w1[4 + e] = d[e]; w2[e] = e2[e]; w2[4 + e] = f[e]; } }
#pragma unroll
    for (int i = 0; i < 8; ++i) {
        float gbv[8], gcv[8], xcv[8], y[8];
        unpack8(gbw[i], gbv); unpack8(gcw[i], gcv); unpack8(xcw[i], xcv);
#pragma unroll
        for (int e = 0; e < 8; ++e) { const float q = gcv[e] * xcv[e]; y[e] = gbv[e] * (w0[e] * q2[e] + w1[e] * q1[e] + w2[e] * q); q2[e] = q1[e]; q1[e] = q; }
        *(u32x4*)(Z + (size_t)(r0 + i) * INC + 2048 + ch0) = pack8(y);
    }
    float* o = nullptr;
    if (prompt) { if (((r0 + 7) & 2047) == 2047) o = p->out + O_SCP + ((size_t)(l * 8 + 4 * h + (r0 >> 11)) * 2) * 1024 + ch0; }
    else o = p->out + O_SCS + ((size_t)(l * 128 + js) * 2) * 1024 + ch0;
    if (o) {
        *(f32x4*)o = (f32x4){q2[0], q2[1], q2[2], q2[3]}; *(f32x4*)(o + 4) = (f32x4){q2[4], q2[5], q2[6], q2[7]};
        *(f32x4*)(o + 1024) = (f32x4){q1[0], q1[1], q1[2], q1[3]}; *(f32x4*)(o + 1028) = (f32x4){q1[4], q1[5], q1[6], q1[7]};
    }
}
__device__ __forceinline__ void mixB_prompt_item(KP p, int l, int item, unsigned char* smem) {
    bf16_t* Z = (bf16_t*)(p->ws + WS_Z);
    const int tid = opaque_tid(), lane = tid & 63, wid = tid >> 6, fr = lane & 15, fq = lane >> 4;
    const int chunk = item >> 2, cb = item & 3;
    const int r0 = (chunk >> 4) * 2048 + (chunk & 15) * 128;
    float* st = (float*)smem; unsigned* vnT = (unsigned*)(smem + 1024);
    const float* lng = p->in[20] + (size_t)l * 1024 + cb * 256; const float* lnb = p->in[21] + (size_t)l * 1024 + cb * 256;
    const bf16_t* CW = (const bf16_t*)(p->ws + WS_CMW) + (size_t)l * 16 * 128 * 128;
    const float* bs = p->in[23] + (size_t)l * 16 * 128;
    u32x4 va[4], vb[4];
#pragma unroll
    for (int i = 0; i < 4; ++i) { const bf16_t* vr = Z + (size_t)(r0 + 2 * lane) * INC + 2048 + cb * 256 + (wid * 4 + i) * 8; va[i] = *(const u32x4*)vr; vb[i] = *(const u32x4*)(vr + INC); }
    if (tid < 128) { float mean, rstd; ln_from_partials((const float*)(p->ws + WS_VS) + (size_t)(r0 + tid) * 32, mean, rstd); st[tid * 2] = mean; st[tid * 2 + 1] = rstd; }
    __syncthreads();
    {
        const f32x4 sm = *(const f32x4*)(st + 4 * lane);
#pragma unroll
        for (int i = 0; i < 4; ++i) {
            const int chl0 = (wid * 4 + i) * 8;
            const f32x4 g0 = *(const f32x4*)(lng + chl0), g1 = *(const f32x4*)(lng + chl0 + 4), b0 = *(const f32x4*)(lnb + chl0), b1 = *(const f32x4*)(lnb + chl0 + 4);
            float fa[8], fb[8]; unpack8(va[i], fa); unpack8(vb[i], fb);
#pragma unroll
            for (int e = 0; e < 8; ++e) {
                const float gg = e < 4 ? g0[e & 3] : g1[e & 3], bb = e < 4 ? b0[e & 3] : b1[e & 3];
                vnT[(chl0 + e) * 68 + lane] = pk2((fa[e] - sm[0]) * sm[1] * gg + bb, (fb[e] - sm[2]) * sm[3] * gg + bb);
            }
        }
    }
    __syncthreads();
    const int gl = wid >> 1, th = wid & 1, gg = cb * 4 + gl;
    bf16x8 Bf[4][4];
    u32x2 uw[4][4];
#pragma unroll
    for (int ks = 0; ks < 4; ++ks)
#pragma unroll
        for (int ni = 0; ni < 4; ++ni) {
            if (ks * 32 <= 64 * th + 16 * ni + 15) Bf[ks][ni] = *(const bf16x8*)(CW + ((size_t)gg * 128 + 64 * th + 16 * ni + fr) * 128 + ks * 32 + fq * 8);
        }
#pragma unroll
    for (int ni = 0; ni < 4; ++ni)
#pragma unroll
        for (int mi = 0; mi < 4; ++mi) uw[mi][ni] = *(const u32x2*)(Z + (size_t)(r0 + 64 * th + 16 * ni + fr) * INC + 1024 + cb * 256 + gl * 64 + mi * 16 + 4 * fq);
    f32x4 acc[4][4];
#pragma unroll
    for (int a = 0; a < 4; ++a)
#pragma unroll
        for (int b = 0; b < 4; ++b) acc[a][b] = (f32x4){0.f, 0.f, 0.f, 0.f};
#pragma unroll
    for (int ks = 0; ks < 4; ++ks) {
        if (ks * 32 <= 64 * th + 63) {
            bf16x8 A[4];
#pragma unroll
            for (int mi = 0; mi < 4; ++mi) A[mi] = *(const bf16x8*)((const bf16_t*)vnT + (gl * 64 + mi * 16 + fr) * 136 + ks * 32 + fq * 8);
#pragma unroll
            for (int ni = 0; ni < 4; ++ni) {
                if (ks * 32 <= 64 * th + 16 * ni + 15) {
                    const int t = 64 * th + 16 * ni + fr, s0 = ks * 32 + fq * 8;
                    bf16x8 B = Bf[ks][ni];
#pragma unroll
                    for (int e = 0; e < 8; ++e) if (s0 + e > t) B[e] = 0;
#pragma unroll
                    for (int mi = 0; mi < 4; ++mi) acc[mi][ni] = __builtin_amdgcn_mfma_f32_16x16x32_bf16(A[mi], B, acc[mi][ni], 0, 0, 0);
                }
            }
        }
    }
#pragma unroll
    for (int ni = 0; ni < 4; ++ni) {
        const int t = 64 * th + 16 * ni + fr;
        const float bsv = bs[gg * 128 + t];
#pragma unroll
        for (int mi = 0; mi < 4; ++mi) {
            const u32x2 w = uw[mi][ni];
            u32x2 o; o.x = pk2(lo_f(w.x) * (acc[mi][ni][0] + bsv), hi_f(w.x) * (acc[mi][ni][1] + bsv)); o.y = pk2(lo_f(w.y) * (acc[mi][ni][2] + bsv), hi_f(w.y) * (acc[mi][ni][3] + bsv));
            *(u32x2*)(Z + (size_t)(r0 + t) * INC + 1024 + cb * 256 + gl * 64 + mi * 16 + 4 * fq) = o;
        }
    }
    __syncthreads();
}
__device__ __forceinline__ void mixB_sample_item(KP p, int l, int h, int item) {
    bf16_t* Z = (bf16_t*)(p->ws + WS_Z);
    const int tid = opaque_tid(), lane = tid & 63, wid = tid >> 6;
    const int unit = item * 8 + wid, j = unit >> 1, hf = unit & 1, js = 64 * h + j, rb = 8192 + j * 8;
    const int ch0 = hf * 512 + lane * 8, g = ch0 >> 6;
    u32x4 vw[8], uw[8];
#pragma unroll
    for (int t = 0; t < 8; ++t) { const bf16_t* zr = Z + (size_t)(rb + t) * INC + ch0; vw[t] = *(const u32x4*)(zr + 2048); uw[t] = *(const u32x4*)(zr + 1024); }
    float mean, rstd;
    ln_from_partials((const float*)(p->ws + WS_VS) + (size_t)(rb + (lane & 7)) * 32, mean, rstd);
    const float* lng = p->in[20] + (size_t)l * 1024 + ch0; const float* lnb = p->in[21] + (size_t)l * 1024 + ch0;
    float gv[8], bv[8];
    { const f32x4 a = *(const f32x4*)lng, b = *(const f32x4*)(lng + 4), c = *(const f32x4*)lnb, d = *(const f32x4*)(lnb + 4);
#pragma unroll
      for (int e = 0; e < 4; ++e) { gv[e] = a[e]; gv[4 + e] = b[e]; bv[e] = c[e]; bv[4 + e] = d[e]; } }
    float vn[8][8];
#pragma unroll
    for (int t = 0; t < 8; ++t) {
        const float mt = __shfl(mean, t), rt = __shfl(rstd, t);
        float f[8]; unpack8(vw[t], f);
#pragma unroll
        for (int e = 0; e < 8; ++e) vn[t][e] = (f[e] - mt) * rt * gv[e] + bv[e];
        float* o = p->out + O_VS + ((size_t)(l * 128 + js) * 8 + t) * 1024 + ch0;
        *(f32x4*)o = (f32x4){vn[t][0], vn[t][1], vn[t][2], vn[t][3]}; *(f32x4*)(o + 4) = (f32x4){vn[t][4], vn[t][5], vn[t][6], vn[t][7]};
    }
    const float* W = p->in[22] + ((size_t)l * 16 + g) * 128 * 128; const float* bs = p->in[23] + ((size_t)l * 16 + g) * 128;
#pragma unroll
    for (int t = 0; t < 8; ++t) {
        float o[8]; const float b0 = bs[t];
#pragma unroll
        for (int e = 0; e < 8; ++e) o[e] = b0;
#pragma unroll
        for (int s = 0; s <= t; ++s) { const float ww = W[t * 128 + s];
#pragma unroll
            for (int e = 0; e < 8; ++e) o[e] += ww * vn[s][e]; }
        float uf[8]; unpack8(uw[t], uf);
#pragma unroll
        for (int e = 0; e < 8; ++e) o[e] *= uf[e];
        *(u32x4*)(Z + (size_t)(rb + t) * INC + 1024 + ch0) = pack8(o);
    }
}
__device__ __forceinline__ void lru_item(KP p, int l, int h, int pass, int sample, int idx, unsigned char* smem, int slot) {
    bf16_t* Z = (bf16_t*)(p->ws + WS_Z);
    const int tid = opaque_tid(), lane = tid & 63, wid = tid >> 6, fr = lane & 15, fq = lane >> 4;
    const int hb = idx & 3;
    int s = 0, tt = 0, grp = 0, r0;
    if (!sample) { s = idx >> 7; tt = (idx >> 2) & 31; r0 = s * 2048 + tt * 64; }
    else { grp = idx >> 2; r0 = 8192 + grp * 64; }
    bf16_t* xcb = (bf16_t*)(smem + (sample ? 0 : slot * 65536));
    f32x2* AB = (f32x2*)smem;
    unsigned* AP = (unsigned*)(smem + slot * 65536);
    const int hl = wid >> 1, mb = 32 * (wid & 1), hg = hb * 4 + hl;
    const bf16_t* WT = (const bf16_t*)(p->ws + WS_LRUW) + (size_t)(l * 16 + hg) * 128 * 64;
    bf16x8 Bf[8][2];
#pragma unroll
    for (int ni = 0; ni < 8; ++ni)
#pragma unroll
        for (int ks = 0; ks < 2; ++ks) Bf[ni][ks] = *(const bf16x8*)(WT + (size_t)(ni * 16 + fr) * 64 + ks * 32 + fq * 8);
    float lamv[4], bav[4], bxv[4];
#pragma unroll
    for (int ni = 0; ni < 4; ++ni) { const int ch = l * 1024 + hb * 256 + hl * 64 + ni * 16 + fr; lamv[ni] = p->in[19][ch]; bav[ni] = p->in[16][ch]; bxv[ni] = p->in[18][ch]; }
    {
        const int cgp = tid & 31, rq = tid >> 5, ch = hb * 256 + cgp * 8;
        float rows[7][8];
        u32x4 rw[7];
        if (!sample) {
#pragma unroll
            for (int i = 0; i < 7; ++i) {
                const int lr = 4 * rq - 3 + i;
                if (lr >= 0) rw[i] = *(const u32x4*)(Z + (size_t)(r0 + lr) * INC + ch);
                else if (tt == 0) rw[i] = (u32x4){0u, 0u, 0u, 0u};
                else rw[i] = *(const u32x4*)(Z + (size_t)(r0 + lr) * INC + ch);
            }
#pragma unroll
            for (int i = 0; i < 7; ++i) unpack8(rw[i], rows[i]);
        } else {
            const int j = rq >> 1, tb = (rq & 1) * 4;
#pragma unroll
            for (int i = 0; i < 7; ++i) { const int tp = tb - 3 + i; rw[i] = tp >= 0 ? *(const u32x4*)(Z + (size_t)(r0 + j * 8 + tp) * INC + ch) : (u32x4){0u, 0u, 0u, 0u}; }
#pragma unroll
            for (int i = 0; i < 7; ++i) unpack8(rw[i], rows[i]);
            if (tb == 0) {
                const float* sp = p->in[5] + ((size_t)(l * 128 + 64 * h + grp * 8 + j) * 3) * 1024 + ch;
#pragma unroll
                for (int i = 0; i < 3; ++i) { const f32x4 a = *(const f32x4*)(sp + i * 1024), b = *(const f32x4*)(sp + i * 1024 + 4);
#pragma unroll
                    for (int e = 0; e < 4; ++e) { rows[i][e] = a[e]; rows[i][4 + e] = b[e]; } }
            }
        }
        const float* cw = p->in[13] + (size_t)l * 4 * 1024 + ch; const float* cbias = p->in[14] + (size_t)l * 1024 + ch;
        float wk[4][8], bz[8];
#pragma unroll
        for (int k = 0; k < 4; ++k) { const f32x4 a = *(const f32x4*)(cw + k * 1024), b = *(const f32x4*)(cw + k * 1024 + 4);
#pragma unroll
            for (int e = 0; e < 4; ++e) { wk[k][e] = a[e]; wk[k][4 + e] = b[e]; } }
        { const f32x4 a = *(const f32x4*)cbias, b = *(const f32x4*)(cbias + 4);
#pragma unroll
          for (int e = 0; e < 4; ++e) { bz[e] = a[e]; bz[4 + e] = b[e]; } }
#pragma unroll
        for (int o = 0; o < 4; ++o) {
            float a8[8];
#pragma unroll
            for (int e = 0; e < 8; ++e) a8[e] = bz[e] + wk[0][e] * rows[o][e] + wk[1][e] * rows[o + 1][e] + wk[2][e] * rows[o + 2][e] + wk[3][e] * rows[o + 3][e];
            *(u32x4*)(xcb + (4 * rq + o) * 264 + cgp * 8) = pack8(a8);
        }
        {
            if (!sample) { if (tt == 31 && rq == 15) {
#pragma unroll
                for (int i = 0; i < 3; ++i) { float* o = p->out + O_LCP + ((size_t)(l * 8 + 4 * h + s) * 3 + i) * 1024 + ch;
                    *(f32x4*)o = (f32x4){rows[4 + i][0], rows[4 + i][1], rows[4 + i][2], rows[4 + i][3]}; *(f32x4*)(o + 4) = (f32x4){rows[4 + i][4], rows[4 + i][5], rows[4 + i][6], rows[4 + i][7]}; } } }
            else if (rq & 1) {
                const int js = 64 * h + grp * 8 + (rq >> 1);
#pragma unroll
                for (int i = 0; i < 3; ++i) { float* o = p->out + O_LCS + ((size_t)(l * 128 + js) * 3 + i) * 1024 + ch;
                    *(f32x4*)o = (f32x4){rows[4 + i][0], rows[4 + i][1], rows[4 + i][2], rows[4 + i][3]}; *(f32x4*)(o + 4) = (f32x4){rows[4 + i][4], rows[4 + i][5], rows[4 + i][6], rows[4 + i][7]}; }
            }
        }
    }
    __syncthreads();
    f32x4 acc[2][8];
#pragma unroll
    for (int a = 0; a < 2; ++a)
#pragma unroll
        for (int b = 0; b < 8; ++b) acc[a][b] = (f32x4){0.f, 0.f, 0.f, 0.f};
    bf16x8 Af[2][2];
#pragma unroll
    for (int mi = 0; mi < 2; ++mi)
#pragma unroll
        for (int ks = 0; ks < 2; ++ks) Af[mi][ks] = *(const bf16x8*)(xcb + (mb + mi * 16 + fr) * 264 + hl * 64 + ks * 32 + fq * 8);
#pragma unroll
    for (int ni = 0; ni < 8; ++ni)
#pragma unroll
        for (int ks = 0; ks < 2; ++ks)
#pragma unroll
            for (int mi = 0; mi < 2; ++mi) acc[mi][ni] = __builtin_amdgcn_mfma_f32_16x16x32_bf16(Af[mi][ks], Bf[ni][ks], acc[mi][ni], 0, 0, 0);
    float av[2][4][4], bv[2][4][4];
#pragma unroll
    for (int ni = 0; ni < 4; ++ni) {
        const int chl = hl * 64 + ni * 16 + fr;
        const float sp = 0.69314718f * __builtin_amdgcn_logf(1.f + __builtin_amdgcn_exp2f(-1.44269504f * lamv[ni]));
        const float ka = -8.f * 1.44269504f * sp, car_ = -1.44269504f * bav[ni], cxi = -1.44269504f * bxv[ni];
#pragma unroll
        for (int mi = 0; mi < 2; ++mi)
#pragma unroll
            for (int jj = 0; jj < 4; ++jj) {
                const int row = mb + mi * 16 + 4 * fq + jj;
                const float er = 1.f + __builtin_amdgcn_exp2f(fminf(-1.44269504f * acc[mi][ni][jj] + car_, 60.f));
                const float ei = 1.f + __builtin_amdgcn_exp2f(fminf(-1.44269504f * acc[mi][ni + 4][jj] + cxi, 60.f));
                const float inv = __builtin_amdgcn_rcpf(er * ei);
                const float rg = inv * ei, ig = inv * er;
                const float xv = bf2f(xcb[row * 264 + chl]);
                float tq = ka * rg;
                if (!sample) tq = (float)(_Float16)tq;
                const float a = __builtin_amdgcn_exp2f(tq);
                av[mi][ni][jj] = sample ? a : tq;
                bv[mi][ni][jj] = __builtin_amdgcn_sqrtf(fmaxf(1.f - a * a, 0.f)) * ig * xv;
            }
    }
    const int chs = hb * 256 + (tid & 255);
    float h0s[8];
    if (sample && tid < 256) {
#pragma unroll
        for (int j = 0; j < 8; ++j) h0s[j] = p->in[4][(size_t)(l * 128 + 64 * h + grp * 8 + j) * 1024 + chs];
    }
    __syncthreads();
#pragma unroll
    for (int ni = 0; ni < 4; ++ni)
#pragma unroll
        for (int mi = 0; mi < 2; ++mi)
#pragma unroll
            for (int jj = 0; jj < 4; ++jj) {
                const int e_ = (mb + mi * 16 + 4 * fq + jj) * 256 + hl * 64 + ni * 16 + fr;
                if (sample) AB[e_] = (f32x2){av[mi][ni][jj], bv[mi][ni][jj]};
                else { const _Float16 th = (_Float16)av[mi][ni][jj]; AP[e_] = (unsigned)__builtin_bit_cast(unsigned short, th) | (pk2(0.f, bv[mi][ni][jj]) & 0xffff0000u); }
            }
    __syncthreads();
    if (tid < 256) {
        if (!sample) {
            float hh = 0.f, P = 1.f;
#pragma unroll 16
            for (int row = 0; row < 64; ++row) { const unsigned w = AP[row * 256 + tid]; const float a = __builtin_amdgcn_exp2f((float)__builtin_bit_cast(_Float16, (unsigned short)(w & 0xffffu))); hh = a * hh + hi_f(w); P *= a; }
            *(f32x2*)((float*)(p->ws + WS_CAR) + ((size_t)(s * 32 + tt) * 1024 + chs) * 2) = (f32x2){P, hh};
        } else {
#pragma unroll
            for (int j = 0; j < 8; ++j) {
                float hh = h0s[j];
#pragma unroll
                for (int t = 0; t < 8; ++t) { const int row = j * 8 + t; const f32x2 ab = AB[row * 256 + tid]; hh = ab.x * hh + ab.y; AB[row * 256 + tid].x = hh; }
                p->out[O_HS + (size_t)(l * 128 + 64 * h + grp * 8 + j) * 1024 + chs] = hh;
            }
        }
    }
    __syncthreads();
    if (sample) {
#pragma unroll
        for (int i = 0; i < 8; ++i) {
            const int row = wid * 8 + i;
#pragma unroll
            for (int j = 0; j < 2; ++j) {
                const f32x4 v = *(const f32x4*)&AB[row * 256 + (lane + 64 * j) * 2];
                *(unsigned*)(Z + (size_t)(r0 + row) * INC + hb * 256 + (lane + 64 * j) * 2) = pk2(v[0], v[2]);
            }
        }
        __syncthreads();
    }
}

__device__ __forceinline__ void lru_finish(KP p, int l, int h, int idx, unsigned char* smem, int slot) {
    bf16_t* Z = (bf16_t*)(p->ws + WS_Z);
    const int tid = opaque_tid(), lane = tid & 63, wid = tid >> 6;
    const int hb = idx & 3, s = idx >> 7, tt = (idx >> 2) & 31, r0 = s * 2048 + tt * 64;
    unsigned* AP = (unsigned*)(smem + slot * 65536);
    if (tid < 256) {
        const int chs = hb * 256 + tid;
        const float* car = (const float*)(p->ws + WS_CAR);
        f32x2 cr[31];
#pragma unroll
        for (int k = 0; k < 31; ++k) if (k < tt) cr[k] = *(const f32x2*)(car + ((size_t)(s * 32 + k) * 1024 + chs) * 2);
        float hh = 0.f;
#pragma unroll
        for (int k = 0; k < 31; ++k) if (k < tt) hh = cr[k].x * hh + cr[k].y;
#pragma unroll 16
        for (int row = 0; row < 64; ++row) { const unsigned w = AP[row * 256 + tid]; const float a = __builtin_amdgcn_exp2f((float)__builtin_bit_cast(_Float16, (unsigned short)(w & 0xffffu))); hh = a * hh + hi_f(w); AP[row * 256 + tid] = __float_as_uint(hh); }
        if (tt == 31) p->out[O_HP + (size_t)(l * 8 + 4 * h + s) * 1024 + chs] = hh;
    }
    __syncthreads();
#pragma unroll
    for (int i = 0; i < 8; ++i) {
        const int row = wid * 8 + i;
        const f32x4 v = *(const f32x4*)(const void*)&AP[row * 256 + lane * 4];
        u32x2 o; o.x = pk2(v[0], v[1]); o.y = pk2(v[2], v[3]);
        *(u32x2*)(Z + (size_t)(r0 + row) * INC + hb * 256 + lane * 4) = o;
    }
    __syncthreads();
}

#ifndef PHM
#define PHM 0xFFFF
#endif
#ifndef NSYNC
#define NSYNC 1
#endif
#define GSYNC do { FRESH_P; XcdBarrier xb_; xb_.bar = (unsigned*)(p->ws + WS_BAR); xb_.x = xb_xcc_id(); xb_.st = (volatile LAS unsigned*)((LAS unsigned char*)smem + 131072); xcd_barrier(xb_); } while (0)
__global__ void __launch_bounds__(512) mega(Params p_unused) {
    cg::grid_group grid = cg::this_grid();
    extern __shared__ __attribute__((aligned(16))) unsigned char smem[];
    LAS unsigned char* lds = (LAS unsigned char*)smem;
    volatile LAS unsigned* xst = (volatile LAS unsigned*)(lds + 131072);
    if (threadIdx.x == 0) { xst[0] = 0u; xst[1] = 0u; }
    __syncthreads();
    { FRESH_P; (void)xcd_barrier_post((unsigned*)(p->ws + WS_BAR), xst); }

    if (PHM & 1) { FRESH_P; p0_convert(p, smem, 0, blockIdx.x, gridDim.x); }
    { FRESH_P; if (p->ws == nullptr) grid.sync(); }
    GSYNC;
    if (PHM & 3) {
        FRESH_P;
        if (blockIdx.x < 48) {
            unsigned char* ws = p->ws;
            pg8::Gemm g{(const bf16_t*)(ws + WS_CA), (const bf16_t*)(ws + WS_Z), 1024, 1024, 1024, 0, 0};
            pg8::Order S; S.init(1, 48, 1, gridDim.x, blockIdx.x, 16);
            EpiMod E{(float*)(ws + WS_MOD), p->in[8]};
            pg8::gemm_phase(lds, g, S, E);
        } else p0_convert(p, smem, 1, blockIdx.x - 48, gridDim.x - 48);
    }
    GSYNC;
    if (PHM & 4) {
        FRESH_P; unsigned char* ws = p->ws;
        const int G = gridDim.x, bid = blockIdx.x;
        int off = 0;
        for (int q = 0; q < 6; ++q) {
            const int l = q / 3, kind = q % 3, N = kind == 0 ? 6144 : (kind == 1 ? 3072 : DFF);
            const bf16_t* Bt = kind == 0 ? (const bf16_t*)(ws + WS_WIN) + (size_t)l * 6144 * 1024
                             : kind == 1 ? (const bf16_t*)(ws + WS_Z + ZT_GATE) + (size_t)l * 3072 * 1024 : (const bf16_t*)(ws + WS_WF1) + (size_t)l * DFF * 1024;
            pg8::Gemm g{(const bf16_t*)(ws + WS_SHA) + (size_t)(l * 2 + (kind == 2)) * 256 * 1024, Bt, 1024, 1024, 1024, 0, 0};
            pg8::Order S; S.init(1, N / 256, 1, G, (bid - off + G) % G, 16);
            { pg8::Unit u0; if (S.next(0, u0)) sha_prepare(p, l * 2 + (kind == 2)); }
            EpiSW E{kind == 2 ? (float*)(ws + WS_SW2) + (size_t)l * NBATCH * DFF : (float*)(ws + WS_SW1) + (size_t)l * NBATCH * INC + (kind == 1 ? 6144 : 0), kind == 2 ? DFF : INC};
            pg8::gemm_phase(lds, g, S, E);
            off = (off + N / 256) % G;
        }
        derive_pass(p);
        xg0_pass(p, 0);
    }
    GSYNC;

    for (int hl = 0; hl < 4; ++hl) {
        int h = hl >> 1, l = hl & 1;
        asm volatile("" : "+s"(h), "+s"(l));
        if (PHM & 8) {
            FRESH_P; unsigned char* ws = p->ws;
            {
                pg8::Gemm g{(const bf16_t*)(ws + WS_XG), (const bf16_t*)(ws + WS_WIN) + (size_t)l * 6144 * 1024, 1024, 1024, 1024, 0, 0};
                pg8::Order S; S.init(34, 24, 1, gridDim.x, blockIdx.x, 16);
                EpiG1 E{(bf16_t*)(ws + WS_Z), (const float*)(ws + WS_RSA), (const float*)(ws + WS_SW1) + (size_t)l * NBATCH * INC, h, (float*)(ws + WS_VS), 0};
                pg8::gemm_phase(lds, g, S, E);
            }
            {
                pg8::Gemm g{(const bf16_t*)(ws + WS_XG8), (const bf16_t*)(ws + WS_W8) + (size_t)l * 3072 * 512, 512, 512, 512, 0, 0};
                pg8::Order S; S.init(34, 12, 1, (int)gridDim.x - 48, blockIdx.x >= 48 ? (int)blockIdx.x - 48 : (1 << 28), 8);
                EpiGate E{(bf16_t*)(ws + WS_Z), (const float*)(ws + WS_RSA), (const float*)(ws + WS_SW1) + (size_t)l * NBATCH * INC, h};
                pg8::gemm_phase<EpiGate, pg8::Order, true>(lds, g, S, E);
            }
        }
        GSYNC;
        if (PHM & 16) {
            FRESH_P;
            for (int it = blockIdx.x; it < 256 + 16; it += gridDim.x) {
                if (it < 256) mixB_prompt_item(p, l, it, smem);
                else mixB_sample_item(p, l, h, it - 256);
            }
#pragma unroll 1
            for (int slot = 0; slot < 2; ++slot) lru_item(p, l, h, 1, 0, blockIdx.x + 256 * slot, smem, slot);
        }
        GSYNC;
        if (PHM & 32) {
            FRESH_P;
#pragma unroll 1
            for (int slot = 0; slot < 2; ++slot) lru_finish(p, l, h, blockIdx.x + 256 * slot, smem, slot);
            if (blockIdx.x < 32) lru_item(p, l, h, 2, 1, blockIdx.x, smem, 0);
            else for (int it = blockIdx.x - 32; it < 272; it += gridDim.x - 32) mixC_item(p, l, h, it);
        }
        GSYNC;
        if (PHM & 64) {
            FRESH_P; unsigned char* ws = p->ws; bf16_t* Z = (bf16_t*)(ws + WS_Z);
            pg8::Gemm g{Z, (const bf16_t*)(ws + WS_WBR) + (size_t)l * 3 * 1024 * 1024, INC, 1024, 1024, 1024, (size_t)1024 * 1024};
            pg8::Order S; S.init(34, 4, 3, gridDim.x, blockIdx.x, 16);
            EpiBR E{Z};
            pg8::gemm_phase(lds, g, S, E);
        }
        GSYNC;
        if (PHM & 64) { FRESH_P; sum_pass(p); }
        GSYNC;
        if (PHM & 128) {
            FRESH_P; unsigned char* ws = p->ws;
            pg8::Gemm g{(const bf16_t*)(ws + WS_Z) + 6144, (const bf16_t*)(ws + WS_WO3) + (size_t)l * 1024 * 1024, INC, 1024, 1024, 0, 0};
            pg8::Order S; S.init(34, 4, 1, gridDim.x, blockIdx.x, 16);
            EpiRes<false> E{p->in[0], p->in[1], p->out, (const float*)(ws + WS_MOD) + l * 6144 + 2048, (const float*)(ws + WS_GB) + (size_t)(l * 2 + 1) * NBATCH * 1024,
                     (bf16_t*)(ws + WS_XG), (float*)(ws + WS_RSB), h, l == 0, 0, nullptr, nullptr, nullptr, 0};
            pg8::gemm_phase(lds, g, S, E);
        }
        GSYNC;
        if (PHM & 256) {
            FRESH_P; unsigned char* ws = p->ws;
            pg8::Gemm g{(const bf16_t*)(ws + WS_XG), (const bf16_t*)(ws + WS_WF1) + (size_t)l * DFF * 1024, 1024, 1024, 1024, 0, 0};
            pg8::Order S; S.init(32, 16, 1, gridDim.x, blockIdx.x, 16);
            EpiFF1 E{(bf16_t*)(ws + WS_Z), (const float*)(ws + WS_RSB), (const float*)(ws + WS_SW2) + (size_t)l * NBATCH * DFF, h, nullptr};
            pg8::gemm_phase(lds, g, S, E);
        }
        GSYNC;
        if (PHM & 512) {
            FRESH_P; unsigned char* ws = p->ws;
            unsigned* skf = (unsigned*)(ws + WS_BAR + 16384) + (h * 2 + l) * 256;
            unsigned* pdone = (unsigned*)(ws + WS_BAR + 16384 + 8192) + (h * 2 + l) * 64;
            if (blockIdx.x >= 224) {
                const int j = (int)blockIdx.x - 224;
                {
                    pg8::Gemm g{(const bf16_t*)(ws + WS_XG), (const bf16_t*)(ws + WS_WF1) + (size_t)l * DFF * 1024, 1024, 1024, 1024, 0, 0};
                    pg8::OrderOne S1{32 + (j >> 4), j & 15, 16};
                    EpiFF1 E{(bf16_t*)(ws + WS_Z), (const float*)(ws + WS_RSB), (const float*)(ws + WS_SW2) + (size_t)l * NBATCH * DFF, h, pdone + (j >> 4) * 32};
                    pg8::gemm_phase(lds, g, S1, E);
                }
                if (threadIdx.x < 64) {
                    unsigned sp = 0;
                    while (xb_ld(pdone + (j >> 4) * 32) < 16u) { __builtin_amdgcn_s_sleep(2); if (++sp > (1u << 22)) break; }
                    __builtin_amdgcn_fence(__ATOMIC_ACQUIRE, "agent");
                    asm volatile("s_waitcnt vmcnt(0)" ::: "memory");
                }
                __syncthreads();
            }
            pg8::Gemm g{(const bf16_t*)(ws + WS_Z), (const bf16_t*)(ws + WS_WF2) + (size_t)l * 1024 * DFF, DFF, DFF, DFF, 0, 0};
            pg8::OrderSK S; S.c = blockIdx.x;
            EpiRes<true> E{nullptr, nullptr, p->out, (const float*)(ws + WS_MOD) + l * 6144 + 5120, l == 0 ? (const float*)(ws + WS_GB) + (size_t)2 * NBATCH * 1024 : nullptr,
                     (bf16_t*)(ws + WS_XG), l == 0 ? (float*)(ws + WS_RSA) : (float*)(ws + WS_RSF), h, 0, l == 1, ws + WS_XG8,
                     (float*)(ws + WS_Z + (72ull << 20)), skf, (int)blockIdx.x};
            pg8::gemm_phase(lds, g, S, E);
            if (h == 0 && l == 1) xg0_pass(p, 1);
        }
        GSYNC;
    }
    if (PHM & 1024) { FRESH_P; final_pass(p); }
}

extern "C" void kernel_launch(void* const* d_in, const int* in_sizes, int n_in, void* d_out, int out_size, void* d_ws, size_t ws_size, hipStream_t stream) {
    static int grid_blocks = 0;
    if (grid_blocks == 0) {
        if (n_in != 31 || ws_size < WS_END) { fprintf(stderr, "kernel_launch: need 31 inputs and %zu bytes of workspace, got %d / %zu\n", (size_t)WS_END, n_in, ws_size); grid_blocks = -1; return; }
        int dev = 0, cus = 0, per_cu = 0;
        hipGetDevice(&dev);
        hipDeviceGetAttribute(&cus, hipDeviceAttributeMultiprocessorCount, dev);
        hipFuncSetAttribute((const void*)mega, hipFuncAttributeMaxDynamicSharedMemorySize, LDS_BYTES);
        hipOccupancyMaxActiveBlocksPerMultiprocessor(&per_cu, (const void*)mega, 512, LDS_BYTES);
        if (per_cu < 1) { fprintf(stderr, "kernel_launch: occupancy query says %d blocks per CU\n", per_cu); per_cu = 1; }
        if (per_cu > 1) per_cu = 1;
        grid_blocks = cus * per_cu;
        if (grid_blocks != 256) { fprintf(stderr, "kernel_launch: built for a 256-CU device, got %d\n", grid_blocks); if (grid_blocks > 256) grid_blocks = 256; else { grid_blocks = -1; return; } }
    }
    if (grid_blocks < 0) return;
    Params p{};
    for (int i = 0; i < 31; ++i) p.in[i] = (const float*)d_in[i];
    p.out = (float*)d_out; p.ws = (unsigned char*)d_ws;
    if (hipMemsetAsync((unsigned char*)d_ws + WS_BAR, 0, 32768, stream) != hipSuccess) { fprintf(stderr, "kernel_launch: memset of the barrier words failed\n"); return; }
    void* args[] = {&p};
    hipError_t e = hipLaunchCooperativeKernel((const void*)mega, dim3(grid_blocks), dim3(512), args, LDS_BYTES, stream);
    if (e != hipSuccess) fprintf(stderr, "cooperative launch failed: %s (grid %d)\n", hipGetErrorString(e), grid_blocks);
}
```

```cpp
#include <hip/hip_runtime.h>
#include <hip/hip_cooperative_groups.h>
#include <cstdio>
#include <cstdint>
namespace cg = cooperative_groups;

#define LAS __attribute__((address_space(3)))
typedef unsigned short bf16_t;
typedef short bf16x8 __attribute__((ext_vector_type(8)));
typedef float f32x4 __attribute__((ext_vector_type(4)));
typedef float f32x2 __attribute__((ext_vector_type(2)));
typedef unsigned u32x4 __attribute__((ext_vector_type(4)));
typedef unsigned u32x2 __attribute__((ext_vector_type(2)));
typedef int i32x4 __attribute__((ext_vector_type(4)));
typedef int i32x8 __attribute__((ext_vector_type(8)));

constexpr int D = 1024, NBATCH = 136, MH = 8704, MT = 17408, INC = 9216, DFF = 4096;
constexpr float EPS = 1e-6f;
constexpr size_t O_YP = 0, O_HP = 17825792, O_LCP = O_HP + 16384, O_SCP = O_LCP + 49152, O_HS = O_SCP + 32768,
                 O_LCS = O_HS + 262144, O_SCS = O_LCS + 786432, O_VS = O_SCS + 524288;
constexpr size_t WS_WIN = 0;
constexpr size_t WS_WBR = WS_WIN + 2ull * 6144 * 1024 * 2;
constexpr size_t WS_WO3 = WS_WBR + 2ull * 3 * 1024 * 1024 * 2;
constexpr size_t WS_WF1 = WS_WO3 + 2ull * 1024 * 1024 * 2;
constexpr size_t WS_WF2 = WS_WF1 + 2ull * 4096 * 1024 * 2;
constexpr size_t WS_LRUW = WS_WF2 + 2ull * 1024 * 4096 * 2;
constexpr size_t WS_CMW = WS_LRUW + 2ull * 16 * 128 * 64 * 2;
constexpr size_t WS_CA = WS_CMW + 2ull * 16 * 128 * 128 * 2;
constexpr size_t WS_SHA = WS_CA + 256ull * 1024 * 2;
constexpr size_t WS_MOD = WS_SHA + 4ull * 256 * 1024 * 2;
constexpr size_t WS_GB = WS_MOD + 136ull * 12288 * 4;
constexpr size_t WS_SW1 = WS_GB + 4ull * 136 * 1024 * 4;
constexpr size_t WS_SW2 = WS_SW1 + 2ull * 136 * 9216 * 4;
constexpr size_t WS_RSA = WS_SW2 + 2ull * 136 * 4096 * 4;
constexpr size_t WS_RSB = WS_RSA + 8704ull * 16 * 4;
constexpr size_t WS_RSF = WS_RSB + 8704ull * 16 * 4;
constexpr size_t WS_CAR = WS_RSF + 17408ull * 16 * 4;
constexpr size_t WS_XG = WS_CAR + 4ull * 32 * 1024 * 2 * 4;
constexpr size_t WS_Z = WS_XG + 8704ull * 1024 * 2;
constexpr size_t WS_VS = WS_Z + 8704ull * 9216 * 2;
constexpr size_t WS_BAR = WS_VS + 8704ull * 32 * 4;
constexpr size_t WS_W8 = WS_BAR + 32768;
constexpr size_t WS_XG8 = WS_W8 + 2ull * 3072 * 1024;
constexpr size_t WS_END = WS_XG8 + 8704ull * 1024;
constexpr size_t ZT_GATE = 32ull << 20;
constexpr int LDS_BYTES = 131072 + 2048;

struct Params { const float* in[31]; float* out; unsigned char* ws; };
typedef const __attribute__((address_space(4))) Params* KP;
#define FRESH_P KP p = (KP)__builtin_amdgcn_kernarg_segment_ptr(); asm volatile("" : "+s"(p))
__device__ __forceinline__ int opaque_tid() { int t = threadIdx.x; asm volatile("" : "+v"(t)); return t; }

__device__ __forceinline__ float bf2f(bf16_t v) { return __uint_as_float(((unsigned)v) << 16); }
__device__ __forceinline__ unsigned pk2(float lo, float hi) { unsigned r; asm volatile("v_cvt_pk_bf16_f32 %0, %1, %2" : "=v"(r) : "v"(lo), "v"(hi)); return r; }
__device__ __forceinline__ float lo_f(unsigned w) { return __uint_as_float(w << 16); }
__device__ __forceinline__ float hi_f(unsigned w) { return __uint_as_float(w & 0xffff0000u); }
__device__ __forceinline__ void unpack8(u32x4 w, float* f) { f[0] = lo_f(w.x); f[1] = hi_f(w.x); f[2] = lo_f(w.y); f[3] = hi_f(w.y); f[4] = lo_f(w.z); f[5] = hi_f(w.z); f[6] = lo_f(w.w); f[7] = hi_f(w.w); }
__device__ __forceinline__ u32x4 pack8(const float* f) { u32x4 o; o.x = pk2(f[0], f[1]); o.y = pk2(f[2], f[3]); o.z = pk2(f[4], f[5]); o.w = pk2(f[6], f[7]); return o; }
__device__ __forceinline__ unsigned pk4_fp8(float a, float b, float c, float d) { int w = 0; w = __builtin_amdgcn_cvt_pk_fp8_f32(a, b, w, false); w = __builtin_amdgcn_cvt_pk_fp8_f32(c, d, w, true); return (unsigned)w; }
__device__ __forceinline__ float sigm(float v) { return __builtin_amdgcn_rcpf(1.f + __builtin_amdgcn_exp2f(-1.44269504f * v)); }
__device__ __forceinline__ float wave_sum(float v) {
#pragma unroll
    for (int o = 1; o < 64; o <<= 1) v += __shfl_xor(v, o);
    return v;
}
__device__ __forceinline__ float sum16(const float* p) {
    const f32x4 a = *(const f32x4*)p, b = *(const f32x4*)(p + 4), c = *(const f32x4*)(p + 8), d = *(const f32x4*)(p + 12);
    return (((a.x + a.y) + (a.z + a.w)) + ((b.x + b.y) + (b.z + b.w))) + (((c.x + c.y) + (c.z + c.w)) + ((d.x + d.y) + (d.z + d.w)));
}
__device__ __forceinline__ int grow_of(int r, int h) { return r < 8192 ? h * 8192 + r : 16384 + h * 512 + (r - 8192); }
__device__ __forceinline__ int batch_of(int grow) { return grow < 16384 ? (grow >> 11) : 8 + ((grow - 16384) >> 3); }
#define LDS_WAIT() asm volatile("s_waitcnt lgkmcnt(0)" ::: "memory")


#define XB_TMO      128
#define XB_XCNT(j)  (256  + 64 * (j))
#define XB_XSUB(j)  (1280 + 64 * (j))
#define XB_XGEN(j)  (2304 + 64 * (j))
#define XB_TOP      3328
#define XB_TOPGEN   3392
#define XCD_BAR_WORDS 3456
#define XB_SPIN_CAP (1u << 18)
__device__ __forceinline__ unsigned xb_ld(unsigned* p)              { return __hip_atomic_load(p, __ATOMIC_RELAXED, __HIP_MEMORY_SCOPE_AGENT); }
__device__ __forceinline__ unsigned xb_add(unsigned* p, unsigned v) { return __hip_atomic_fetch_add(p, v, __ATOMIC_RELAXED, __HIP_MEMORY_SCOPE_AGENT); }
__device__ __forceinline__ unsigned xb_xcc_id() { return (unsigned)__builtin_amdgcn_s_getreg((3 << 11) | 20) & 0xFu; }
#define XB_SPIN(cond, bar) do { unsigned _sp = 0; while (cond) { __builtin_amdgcn_s_sleep(1); \
    if ((++_sp & 255u) == 0u) { if (xb_ld(&(bar)[XB_TMO])) break; if (_sp > XB_SPIN_CAP) { atomicAdd(&(bar)[XB_TMO], 1u); break; } } } } while (0)
struct XcdBarrier { unsigned* bar; unsigned x; volatile LAS unsigned* st; };
__device__ __forceinline__ XcdBarrier xcd_barrier_post(unsigned* bar, volatile LAS unsigned* st) {
    XcdBarrier b; b.bar = bar; b.x = xb_xcc_id(); b.st = st;
    if (threadIdx.x == 0) (void)xb_add(&bar[XB_XCNT(b.x)], 1u);
    return b;
}
__device__ __forceinline__ void xcd_barrier_complete(unsigned* bar, unsigned x, unsigned& nloc, unsigned& nx) {
    const unsigned G = gridDim.x * gridDim.y * gridDim.z;
    unsigned sum, cnt, mine, sp = 0u;
    for (;;) {
        sum = 0u; cnt = 0u; mine = 0u;
#pragma unroll
        for (unsigned j = 0; j < 16; ++j) { const unsigned c = xb_ld(&bar[XB_XCNT(j)]); sum += c; cnt += (c > 0u) ? 1u : 0u; mine = (j == x) ? c : mine; }
        if (sum == G) break;
        __builtin_amdgcn_s_sleep(1);
        if ((++sp & 255u) == 0u) { if (xb_ld(&bar[XB_TMO])) break; if (sp > XB_SPIN_CAP) { atomicAdd(&bar[XB_TMO], 1u); break; } }
    }
    nloc = mine > 0u ? mine : 1u; nx = cnt > 0u ? cnt : 1u;
}
__device__ __forceinline__ void xcd_barrier(const XcdBarrier& b) {
    asm volatile("s_waitcnt vmcnt(0)" ::: "memory");
    __syncthreads();
    if (threadIdx.x == 0) {
        unsigned* bar = b.bar;
        __builtin_amdgcn_s_waitcnt(0);
        unsigned nloc = b.st[0], nx = b.st[1];
        if (nloc == 0u) { xcd_barrier_complete(bar, b.x, nloc, nx); b.st[0] = nloc; b.st[1] = nx; }
        const unsigned old = xb_add(&bar[XB_XSUB(b.x)], 1u);
        const unsigned gen = old / nloc;
        if (old + 1u == (gen + 1u) * nloc) {
            __builtin_amdgcn_fence(__ATOMIC_RELEASE, "agent");
            asm volatile("s_waitcnt vmcnt(0)" ::: "memory");
            const unsigned og = xb_add(&bar[XB_TOP], 1u);
            const unsigned tg = og / nx;
            if (og + 1u == (tg + 1u) * nx) xb_add(&bar[XB_TOPGEN], 1u);
            else XB_SPIN(xb_ld(&bar[XB_TOPGEN]) == tg, bar);
            __builtin_amdgcn_fence(__ATOMIC_ACQUIRE, "agent");
            xb_add(&bar[XB_XGEN(b.x)], 1u);
            asm volatile("s_waitcnt vmcnt(0)" ::: "memory");
        } else {
            XB_SPIN(xb_ld(&bar[XB_XGEN(b.x)]) == gen, bar);
            __builtin_amdgcn_fence(__ATOMIC_ACQUIRE, "agent");
            asm volatile("s_waitcnt vmcnt(0)" ::: "memory");
        }
    }
    __syncthreads();
}

namespace pg8 {
constexpr int BM = 256, BK = 64, HALF = 128, HTB = HALF * BK * 2, NXCD = 8, WGM = 8;
__device__ __forceinline__ int lds_byte(int r, int c) { const int st = (r >> 4) * 2 + (c >> 5), rr = r & 15, cc = c & 31, ob = rr * 64 + cc * 2; return st * 1024 + (ob ^ (((ob >> 9) & 1) << 5)); }
__device__ __forceinline__ void stage_rc(int b, int& R, int& C) { const int st = b / 1024, sb = b % 1024, swz = sb ^ (((sb >> 9) & 1) << 5); R = (st >> 1) * 16 + swz / 64; C = (st & 1) * 32 + (swz % 64) / 2; }
__device__ __forceinline__ int perm32(int rho) { const int n = rho >> 4, i = rho & 15; return 8 * (i >> 2) + 4 * n + (i & 3); }

struct Unit { int pm, pn, g, k0, nkt, role, np; };
struct Gemm { const bf16_t* A; const bf16_t* Bt; int lda, ldb, K; size_t a_gs, b_gs; };
struct Order {
    int nM, nN, nwg, ngrp, G, c, nt;
    __device__ __forceinline__ void init(int nM_, int nN_, int ngrp_, int G_, int c_, int nt_) { nM = nM_; nN = nN_; nwg = nM * nN; ngrp = ngrp_; G = G_; c = c_; nt = nt_; }
    __device__ __forceinline__ bool next(int i, Unit& u) const {
        const int L = i * G + c; if (L >= nwg * ngrp) return false;
        u.g = L / nwg; int wgid = L % nwg; u.k0 = 0; u.nkt = nt; u.role = 0; u.np = 0;
        { const int q = nwg / NXCD, r = nwg % NXCD, xcd = wgid % NXCD, off = wgid / NXCD; wgid = (xcd < r ? xcd * (q + 1) : r * (q + 1) + (xcd - r) * q) + off; }
        const int nig = WGM * nN, gid = wgid / nig, fm = gid * WGM, gsz = (nM - fm) < WGM ? (nM - fm) : WGM;
        u.pm = fm + ((wgid % nig) % gsz); u.pn = (wgid % nig) / gsz; return true;
    }
};
struct OrderSK {
    int c;
    static __device__ __forceinline__ int len_of(int b) { return b < 64 ? 38 : (b < 224 ? 36 : 16); }
    static __device__ __forceinline__ int beg_of(int b) { return b < 64 ? 38 * b : (b < 224 ? 2432 + 36 * (b - 64) : 8192 + 16 * (b - 224)); }
    __device__ __forceinline__ bool next(int i, Unit& u) const {
        const int beg = beg_of(c), len = len_of(c), T0 = beg >> 6, k0 = beg & 63, n0 = (64 - k0) < len ? (64 - k0) : len;
        int T, kk, n;
        if (i == 0) { T = T0; kk = k0; n = n0; }
        else if (i == 1 && n0 < len) { T = T0 + 1; kk = 0; n = len - n0; }
        else return false;
        u.pm = T >> 2; u.pn = T & 3; u.g = 0; u.k0 = kk; u.nkt = n;
        if (kk > 0) { u.role = 1; u.np = 0; }
        else { const int rem = 64 - n, l1 = len_of(c + 1), l2 = len_of(c + 2); u.role = 2; u.np = 1 + (rem > l1 ? 1 : 0) + (rem > l1 + l2 ? 1 : 0); }
        return true;
    }
};
struct OrderOne {
    int pm, pn, nt;
    __device__ __forceinline__ bool next(int i, Unit& u) const { if (i != 0) return false; u.pm = pm; u.pn = pn; u.g = 0; u.k0 = 0; u.nkt = nt; u.role = 0; u.np = 0; return true; }
};
template <class Epi, class Sched, bool F8 = false>
__device__ __forceinline__ void gemm_phase(LAS unsigned char* lds, const Gemm g, const Sched& S, const Epi& E) {
    const int tid = opaque_tid(), wid = __builtin_amdgcn_readfirstlane(tid >> 6), lane = tid & 63, wr = wid >> 2, wc = wid & 3, fr = lane & 15, fq = lane >> 4;
    unsigned voffA[2], voffB[2];
#pragma unroll
    for (int i = 0; i < 2; ++i) { int R, C; stage_rc(tid * 16 + i * 8192, R, C); const int Rb = (R & ~31) + perm32(R & 31);
        voffA[i] = (unsigned)(R * g.lda + C) * 2u; voffB[i] = (unsigned)(Rb * g.ldb + C) * 2u; }
    const size_t kstep = (size_t)(BK * 2);
    const size_t hA = (size_t)HALF * g.lda * 2, hB = (size_t)HALF * g.ldb * 2;
    const unsigned ldsw = (unsigned)wid * 1024u;
    const int aoff = lds_byte(wr * 64 + fr, fq * 8), boff = lds_byte(wc * 32 + fr, fq * 8);
#define PG8_SA(b, h) (((b) * 2 + (h)) * HTB)
#define PG8_SB(b, h) ((4 + (b) * 2 + (h)) * HTB)
#define PG8_STAGE(bufoff, gbase, voff) do { _Pragma("unroll") for (int _i = 0; _i < 2; ++_i) \
        __builtin_amdgcn_global_load_lds((const unsigned*)((const char*)(gbase) + (voff)[_i]), (LAS unsigned*)(lds + (bufoff) + ldsw + _i * 8192), 16, 0, 0); } while (0)
#define PG8_LDA(dst, b, h) do { _Pragma("unroll") for (int m = 0; m < 4; ++m) { const i32x4 _l = *(const LAS i32x4*)(lds + PG8_SA(b, h) + aoff + m * 2048), _h = *(const LAS i32x4*)(lds + PG8_SA(b, h) + aoff + m * 2048 + 1024); dst[m] = __builtin_shufflevector(_l, _h, 0, 1, 2, 3, 4, 5, 6, 7); } } while (0)
#define PG8_LDB(dst, b, h) do { _Pragma("unroll") for (int n = 0; n < 2; ++n) { const i32x4 _l = *(const LAS i32x4*)(lds + PG8_SB(b, h) + boff + n * 2048), _h = *(const LAS i32x4*)(lds + PG8_SB(b, h) + boff + n * 2048 + 1024); dst[n] = __builtin_shufflevector(_l, _h, 0, 1, 2, 3, 4, 5, 6, 7); } } while (0)
#define PG8_MMA(ai, bj, At, Bt) do { __builtin_amdgcn_s_setprio(1); _Pragma("unroll") for (int m = 0; m < 4; ++m) _Pragma("unroll") for (int n = 0; n < 2; ++n) { \
        if constexpr (F8) asm volatile("s_nop 1\n\tv_mfma_scale_f32_16x16x128_f8f6f4 %0, %1, %2, %0, %3, %3 op_sel_hi:[0,0,0]" : "+v"(acc[ai][bj][m][n]) : "v"(Bt[n]), "v"(At[m]), "v"(f8sc)); \
        else { acc[ai][bj][m][n] = __builtin_amdgcn_mfma_f32_16x16x32_bf16(__builtin_bit_cast(bf16x8, __builtin_shufflevector(Bt[n], Bt[n], 0, 1, 2, 3)), __builtin_bit_cast(bf16x8, __builtin_shufflevector(At[m], At[m], 0, 1, 2, 3)), acc[ai][bj][m][n], 0, 0, 0); \
               acc[ai][bj][m][n] = __builtin_amdgcn_mfma_f32_16x16x32_bf16(__builtin_bit_cast(bf16x8, __builtin_shufflevector(Bt[n], Bt[n], 4, 5, 6, 7)), __builtin_bit_cast(bf16x8, __builtin_shufflevector(At[m], At[m], 4, 5, 6, 7)), acc[ai][bj][m][n], 0, 0, 0); } } \
        __builtin_amdgcn_s_setprio(0); } while (0)
#define PG8_WAIT_V(n) asm volatile("s_waitcnt vmcnt(" #n ")" ::: "memory")
#define PG8_WAIT_L(n) asm volatile("s_waitcnt lgkmcnt(" #n ")" ::: "memory")
#define PG8_BAR __builtin_amdgcn_s_barrier()
#define PG8_SCHED __builtin_amdgcn_sched_barrier(0)
    Unit cur, nxt; int ui = 0;
    if (!S.next(0, cur)) return;
    f32x4 acc[2][2][4][2];
#pragma unroll
    for (int a = 0; a < 2; ++a)
#pragma unroll
        for (int b = 0; b < 2; ++b)
#pragma unroll
            for (int m = 0; m < 4; ++m)
#pragma unroll
                for (int n = 0; n < 2; ++n) acc[a][b][m][n] = (f32x4){0.f, 0.f, 0.f, 0.f};
    i32x8 At[4], B0[2], B1[2];
    int f8sc = 0x7C7C7C7C;
    asm volatile("" : "+v"(f8sc));
    const char* cA = (const char*)(g.A + (size_t)cur.g * g.a_gs) + (size_t)cur.pm * 2 * hA + (size_t)cur.k0 * kstep;
    const char* cB = (const char*)(g.Bt + (size_t)cur.g * g.b_gs) + (size_t)cur.pn * 2 * hB + (size_t)cur.k0 * kstep;
    PG8_STAGE(PG8_SB(0, 0), cB, voffB); PG8_STAGE(PG8_SB(0, 1), cB + hB, voffB); PG8_STAGE(PG8_SA(0, 0), cA, voffA); PG8_STAGE(PG8_SA(0, 1), cA + hA, voffA);
    if (wr == 1) PG8_BAR;
    PG8_WAIT_V(2); PG8_BAR;
    PG8_STAGE(PG8_SB(1, 0), cB + kstep, voffB); PG8_STAGE(PG8_SA(1, 0), cA + kstep, voffA); PG8_STAGE(PG8_SB(1, 1), cB + hB + kstep, voffB);
    PG8_WAIT_V(6); PG8_BAR;
    for (;;) {
        const bool has_next = S.next(ui + 1, nxt);
        const char* nA = has_next ? (const char*)(g.A + (size_t)nxt.g * g.a_gs) + (size_t)nxt.pm * 2 * hA + (size_t)nxt.k0 * kstep : cA;
        const char* nB = has_next ? (const char*)(g.Bt + (size_t)nxt.g * g.b_gs) + (size_t)nxt.pn * 2 * hB + (size_t)nxt.k0 * kstep : cB;
        const int nt = cur.nkt;
        for (int t = 0; t < nt; t += 2) {
            const bool last = (t == nt - 2);
            const char* a1 = cA + (size_t)(t + 1) * kstep;
            const char* a2 = last ? nA : cA + (size_t)(t + 2) * kstep; const char* b2 = last ? nB : cB + (size_t)(t + 2) * kstep;
            const char* a3 = a2 + kstep; const char* b3 = b2 + kstep;
            PG8_LDB(B0, 0, 0); PG8_LDB(B1, 0, 1); PG8_SCHED; PG8_LDA(At, 0, 0); PG8_STAGE(PG8_SA(1, 1), a1 + hA, voffA);
            PG8_WAIT_V(8); PG8_WAIT_L(0); PG8_BAR; PG8_MMA(0, 0, At, B0); PG8_MMA(0, 1, At, B1); PG8_BAR; PG8_SCHED;
            PG8_LDA(At, 0, 1); PG8_STAGE(PG8_SB(0, 0), b2, voffB); PG8_STAGE(PG8_SB(0, 1), b2 + hB, voffB); PG8_STAGE(PG8_SA(0, 0), a2, voffA);
            PG8_WAIT_V(8); PG8_WAIT_L(0); PG8_BAR; PG8_MMA(1, 0, At, B0); PG8_MMA(1, 1, At, B1); PG8_BAR; PG8_SCHED;
            PG8_LDB(B0, 1, 0); PG8_LDB(B1, 1, 1); PG8_SCHED; PG8_LDA(At, 1, 0); PG8_STAGE(PG8_SA(0, 1), a2 + hA, voffA);
            PG8_WAIT_V(8); PG8_WAIT_L(0); PG8_BAR; PG8_MMA(0, 0, At, B0); PG8_MMA(0, 1, At, B1); PG8_BAR; PG8_SCHED;
            PG8_LDA(At, 1, 1); PG8_STAGE(PG8_SB(1, 0), b3, voffB); PG8_STAGE(PG8_SB(1, 1), b3 + hB, voffB); PG8_STAGE(PG8_SA(1, 0), a3, voffA);
            PG8_WAIT_V(8); PG8_WAIT_L(0); PG8_BAR; PG8_MMA(1, 0, At, B0); PG8_MMA(1, 1, At, B1); PG8_BAR; PG8_SCHED;
        }
        if (wr == 0) PG8_BAR;
        if constexpr (F8) asm volatile("s_nop 15\n\ts_nop 15" ::: "memory");
        E(acc, cur, wr, wc, fr, fq);
        if (!has_next) break;
#pragma unroll
        for (int a = 0; a < 2; ++a)
#pragma unroll
            for (int b = 0; b < 2; ++b)
#pragma unroll
                for (int m = 0; m < 4; ++m)
#pragma unroll
                    for (int n = 0; n < 2; ++n) acc[a][b][m][n] = (f32x4){0.f, 0.f, 0.f, 0.f};
        cur = nxt; cA = nA; cB = nB; ++ui;
        if (wr == 1) PG8_BAR;
    }
    PG8_WAIT_V(0);
    PG8_BAR;
#undef PG8_SA
#undef PG8_SB
#undef PG8_STAGE
#undef PG8_LDA
#undef PG8_LDB
#undef PG8_MMA
#undef PG8_WAIT_V
#undef PG8_WAIT_L
#undef PG8_BAR
#undef PG8_SCHED
}
}
using pg8::Unit;
typedef f32x4 AccT[2][2][4][2];

#define EPI_FOR_ROWS _Pragma("unroll") for (int ai = 0; ai < 2; ++ai) _Pragma("unroll") for (int m = 0; m < 4; ++m)
#define EPI_R (u.pm * 256 + ai * 128 + wr * 64 + m * 16 + fr)

struct EpiMod {
    float* mod; const float* b_ada;
    __device__ __forceinline__ void operator()(const AccT& acc, const Unit& u, int wr, int wc, int fr, int fq) const {
        EPI_FOR_ROWS { const int r = EPI_R;
            if (r < NBATCH) {
#pragma unroll
                for (int bj = 0; bj < 2; ++bj) {
                    const int c0 = u.pn * 256 + bj * 128 + wc * 32 + 8 * fq;
                    const f32x4 b0 = *(const f32x4*)(b_ada + c0), b1 = *(const f32x4*)(b_ada + c0 + 4);
                    *(f32x4*)(mod + (size_t)r * 12288 + c0) = acc[ai][bj][m][0] + b0; *(f32x4*)(mod + (size_t)r * 12288 + c0 + 4) = acc[ai][bj][m][1] + b1;
                }
            }
        }
    }
};
__device__ __forceinline__ void derive_pass(KP p, int wblk, int nblk) {
    const int gt = wblk * 512 + opaque_tid(), NGT = nblk * 512;
    const float* mod = (const float*)(p->ws + WS_MOD); bf16_t* sha = (bf16_t*)(p->ws + WS_SHA); float* gb = (float*)(p->ws + WS_GB);
    for (int i = gt; i < 2 * 2 * NBATCH * 256; i += NGT) {
        const int k = (i & 255) * 4, r = (i >> 8) % NBATCH, q = (i >> 8) / NBATCH, L = q >> 1, which = q & 1;
        const float* mr = mod + (size_t)r * 12288 + L * 6144 + which * 3072 + k;
        const f32x4 sh = *(const f32x4*)mr, sc = *(const f32x4*)(mr + 1024);
        const f32x4 gn = *(const f32x4*)(p->in[which ? 10 : 9] + L * 1024 + k);
        u32x2 w; w.x = pk2(sh[0], sh[1]); w.y = pk2(sh[2], sh[3]);
        *(u32x2*)(sha + ((size_t)q * 256 + r) * 1024 + k) = w;
        *(f32x4*)(gb + ((size_t)q * NBATCH + r) * 1024 + k) = gn * (sc + 1.f);
    }
}
struct EpiSW {
    float* o; int ld;
    __device__ __forceinline__ void operator()(const AccT& acc, const Unit& u, int wr, int wc, int fr, int fq) const {
        EPI_FOR_ROWS { const int r = EPI_R;
            if (r < NBATCH) {
#pragma unroll
                for (int bj = 0; bj < 2; ++bj) { float* p = o + (size_t)r * ld + u.pn * 256 + bj * 128 + wc * 32 + 8 * fq;
                    *(f32x4*)p = acc[ai][bj][m][0]; *(f32x4*)(p + 4) = acc[ai][bj][m][1]; }
            }}
    }
};
struct EpiG1 {
    bf16_t* Z; const float* rss; const float* sw; int h; float* vs; int pn0;
    __device__ __forceinline__ void operator()(const AccT& acc, const Unit& u, int wr, int wc, int fr, int fq) const {
        const int pn_ = u.pn + pn0;
        const bool gate = pn_ >= 24, vcol = (pn_ >> 2) == 2, fastb = u.pm < 32;
        const int colb = pn_ * 256 + wc * 32 + 8 * fq;
        f32x4 swv[2][2];
        if (fastb) { const float* swr = sw + (size_t)(4 * h + (u.pm >> 3)) * INC + colb;
#pragma unroll
            for (int bj = 0; bj < 2; ++bj) { swv[bj][0] = *(const f32x4*)(swr + bj * 128); swv[bj][1] = *(const f32x4*)(swr + bj * 128 + 4); } }
        EPI_FOR_ROWS { const int r = EPI_R;
            const f32x4 q = *(const f32x4*)(rss + (size_t)r * 16 + 4 * fq);
            float ssum = (q[0] + q[1]) + (q[2] + q[3]); ssum += __shfl_xor(ssum, 16); ssum += __shfl_xor(ssum, 32);
            const float rstd = __builtin_amdgcn_rsqf(ssum * (1.f / 1024.f) + EPS);
            if (!fastb) { const float* swr = sw + (size_t)batch_of(grow_of(r, h)) * INC + colb;
#pragma unroll
                for (int bj = 0; bj < 2; ++bj) { swv[bj][0] = *(const f32x4*)(swr + bj * 128); swv[bj][1] = *(const f32x4*)(swr + bj * 128 + 4); } }
            bf16_t* zr = Z + (size_t)r * INC + colb;
            float ls = 0.f, lq = 0.f;
#pragma unroll
            for (int bj = 0; bj < 2; ++bj) {
                f32x4 v0 = acc[ai][bj][m][0] * rstd + swv[bj][0], v1 = acc[ai][bj][m][1] * rstd + swv[bj][1];
                if (gate) {
#pragma unroll
                    for (int e = 0; e < 4; ++e) { v0[e] = sigm(v0[e]); v1[e] = sigm(v1[e]); } }
                u32x4 w; w.x = pk2(v0[0], v0[1]); w.y = pk2(v0[2], v0[3]); w.z = pk2(v1[0], v1[1]); w.w = pk2(v1[2], v1[3]);
                *(u32x4*)(zr + bj * 128) = w;
                if (vcol) {
#pragma unroll
                    for (int e = 0; e < 4; ++e) { ls += v0[e] + v1[e]; lq += v0[e] * v0[e] + v1[e] * v1[e]; }
                }
            }
            if (vcol) {
                ls += __shfl_xor(ls, 16); ls += __shfl_xor(ls, 32); lq += __shfl_xor(lq, 16); lq += __shfl_xor(lq, 32);
                if (fq == 0) *(f32x2*)(vs + (size_t)r * 32 + ((pn_ & 3) * 4 + wc) * 2) = (f32x2){ls, lq};
            }
        }
    }
};
struct EpiGate {
    bf16_t* Z; const float* rss; const float* sw; int h;
    __device__ __forceinline__ void operator()(const AccT& acc, const Unit& u, int wr, int wc, int fr, int fq) const {
        const int colb = (24 + u.pn) * 256 + wc * 32 + 8 * fq;
        EPI_FOR_ROWS { const int r = EPI_R;
            const f32x4 q = *(const f32x4*)(rss + (size_t)r * 16 + 4 * fq);
            float ssum = (q[0] + q[1]) + (q[2] + q[3]); ssum += __shfl_xor(ssum, 16); ssum += __shfl_xor(ssum, 32);
            const float rstd = __builtin_amdgcn_rsqf(ssum * (1.f / 1024.f) + EPS);
            const float* swr = sw + (size_t)batch_of(grow_of(r, h)) * INC + colb;
            bf16_t* zr = Z + (size_t)r * INC + colb;
#pragma unroll
            for (int bj = 0; bj < 2; ++bj) {
                const f32x4 s0 = *(const f32x4*)(swr + bj * 128), s1 = *(const f32x4*)(swr + bj * 128 + 4);
                f32x4 v0 = acc[ai][bj][m][0] * rstd + s0, v1 = acc[ai][bj][m][1] * rstd + s1;
#pragma unroll
                for (int e = 0; e < 4; ++e) { v0[e] = sigm(v0[e]); v1[e] = sigm(v1[e]); }
                u32x4 w; w.x = pk2(v0[0], v0[1]); w.y = pk2(v0[2], v0[3]); w.z = pk2(v1[0], v1[1]); w.w = pk2(v1[2], v1[3]);
                *(u32x4*)(zr + bj * 128) = w;
            }
        }
    }
};
struct EpiBR {
    bf16_t* Z;
    __device__ __forceinline__ void operator()(const AccT& acc, const Unit& u, int wr, int wc, int fr, int fq) const {
        EPI_FOR_ROWS { const int r = EPI_R;
            bf16_t* gp = Z + (size_t)r * INC + 6144 + u.g * 1024 + u.pn * 256 + wc * 32 + 8 * fq;
#pragma unroll
            for (int bj = 0; bj < 2; ++bj) {
                const u32x4 gw = *(const u32x4*)(gp + bj * 128);
                float gf[8]; unpack8(gw, gf);
                const f32x4 a0 = acc[ai][bj][m][0], a1 = acc[ai][bj][m][1];
                u32x4 w; w.x = pk2(a0[0] * gf[0], a0[1] * gf[1]); w.y = pk2(a0[2] * gf[2], a0[3] * gf[3]); w.z = pk2(a1[0] * gf[4], a1[1] * gf[5]); w.w = pk2(a1[2] * gf[6], a1[3] * gf[7]);
                *(u32x4*)(gp + bj * 128) = w;
            }}
    }
};
template <bool SK> struct EpiRes {
    const float* xp; const float* xs; float* out; const float* gatep; const float* Gn; bf16_t* XG; float* rss; int h, from_in, rss_global;
    unsigned char* XG8;
    float* slots; unsigned* flags; int cu;
    __device__ __forceinline__ void operator()(const AccT& acc, const Unit& u, int wr, int wc, int fr, int fq) const {
        if (SK && u.role == 1) {
            const unsigned* ubc = (const unsigned*)slots + (size_t)cu * 32768 + (wr * 4 + wc) * 4096;
            const int li = (fq * 16 + fr) * 4;
#pragma unroll
            for (int ai = 0; ai < 2; ++ai)
#pragma unroll
                for (int bj = 0; bj < 2; ++bj)
#pragma unroll
                    for (int m = 0; m < 4; ++m) {
                        unsigned* ub = (unsigned*)ubc + ((ai * 2 + bj) * 4 + m) * 256;
                        asm volatile("" : "+s"(ub));
                        const f32x4 d0 = acc[ai][bj][m][0], d1 = acc[ai][bj][m][1];
                        u32x4 w; w.x = pk2(d0[0], d0[1]); w.y = pk2(d0[2], d0[3]); w.z = pk2(d1[0], d1[1]); w.w = pk2(d1[2], d1[3]);
                        *(u32x4*)(ub + li) = w;
                    }
            asm volatile("s_waitcnt vmcnt(0)" ::: "memory");
            __builtin_amdgcn_s_barrier();
            if (wr == 0 && wc == 0) {
                __builtin_amdgcn_fence(__ATOMIC_RELEASE, "agent");
                asm volatile("s_waitcnt vmcnt(0)" ::: "memory");
                if ((fq * 16 + fr) == 0) (void)xb_add(flags + cu, 8u);
            }
            return;
        }
        if (SK && u.role == 2) {
            if (wr == 0 && wc == 0) {
                for (int q = 1; q <= u.np; ++q) {
                    unsigned sp = 0;
                    while (xb_ld(flags + cu + q) < 8u) { __builtin_amdgcn_s_sleep(2); if (++sp > (1u << 22)) break; }
                }
                __builtin_amdgcn_fence(__ATOMIC_ACQUIRE, "agent");
                asm volatile("s_waitcnt vmcnt(0)" ::: "memory");
            }
            __builtin_amdgcn_s_barrier();
        }
        const bool fastb = u.pm < 32;
        const int cb = u.pn * 256 + wc * 32 + 8 * fq;
        f32x4 gv[2][2], qv[2][2];
        if (fastb) { const int b = 4 * h + (u.pm >> 3);
#pragma unroll
            for (int bj = 0; bj < 2; ++bj) { const float* gr = gatep + (size_t)b * 12288 + cb + bj * 128; gv[bj][0] = *(const f32x4*)gr; gv[bj][1] = *(const f32x4*)(gr + 4);
                if (Gn) { const float* gg = Gn + (size_t)b * 1024 + cb + bj * 128; qv[bj][0] = *(const f32x4*)gg; qv[bj][1] = *(const f32x4*)(gg + 4); } } }
        EPI_FOR_ROWS { const int r = EPI_R;
            const int grow = grow_of(r, h);
            if (!fastb) { const int b = batch_of(grow);
#pragma unroll
                for (int bj = 0; bj < 2; ++bj) { const float* gr = gatep + (size_t)b * 12288 + cb + bj * 128; gv[bj][0] = *(const f32x4*)gr; gv[bj][1] = *(const f32x4*)(gr + 4);
                    if (Gn) { const float* gg = Gn + (size_t)b * 1024 + cb + bj * 128; qv[bj][0] = *(const f32x4*)gg; qv[bj][1] = *(const f32x4*)(gg + 4); } } }
            const float* xr = (!SK && from_in) ? (grow < 16384 ? xp + (size_t)grow * 1024 : xs + (size_t)(grow - 16384) * 1024) : out + (size_t)grow * 1024;
            float* orow = out + (size_t)grow * 1024;
            float ss = 0.f;
#pragma unroll
            for (int bj = 0; bj < 2; ++bj) {
                const int c0 = cb + bj * 128;
                const f32x4 x0 = *(const f32x4*)(xr + c0), x1 = *(const f32x4*)(xr + c0 + 4);
                f32x4 a0 = acc[ai][bj][m][0], a1 = acc[ai][bj][m][1];
                if (SK && u.role == 2) {
                    const unsigned* ub = (const unsigned*)slots + (size_t)(cu + 1) * 32768 + (wr * 4 + wc) * 4096 + ((ai * 2 + bj) * 4 + m) * 256;
                    asm volatile("" : "+s"(ub));
                    const int li = (fq * 16 + fr) * 4;
                    { const u32x4 w = *(const u32x4*)(ub + li); a0 += (f32x4){lo_f(w.x), hi_f(w.x), lo_f(w.y), hi_f(w.y)}; a1 += (f32x4){lo_f(w.z), hi_f(w.z), lo_f(w.w), hi_f(w.w)}; }
                    if (u.np >= 2) { const u32x4 w = *(const u32x4*)(ub + 32768 + li); a0 += (f32x4){lo_f(w.x), hi_f(w.x), lo_f(w.y), hi_f(w.y)}; a1 += (f32x4){lo_f(w.z), hi_f(w.z), lo_f(w.w), hi_f(w.w)}; }
                    if (u.np >= 3) { const u32x4 w = *(const u32x4*)(ub + 65536 + li); a0 += (f32x4){lo_f(w.x), hi_f(w.x), lo_f(w.y), hi_f(w.y)}; a1 += (f32x4){lo_f(w.z), hi_f(w.z), lo_f(w.w), hi_f(w.w)}; }
                }
                const f32x4 v0 = x0 + gv[bj][0] * a0, v1 = x1 + gv[bj][1] * a1;
                *(f32x4*)(orow + c0) = v0; *(f32x4*)(orow + c0 + 4) = v1;
                ss += (v0[0] * v0[0] + v0[1] * v0[1]) + (v0[2] * v0[2] + v0[3] * v0[3]) + (v1[0] * v1[0] + v1[1] * v1[1]) + (v1[2] * v1[2] + v1[3] * v1[3]);
                if (Gn) {
                    const f32x4 q0 = qv[bj][0], q1 = qv[bj][1];
                    u32x4 w; w.x = pk2(v0[0] * q0[0], v0[1] * q0[1]); w.y = pk2(v0[2] * q0[2], v0[3] * q0[3]); w.z = pk2(v1[0] * q1[0], v1[1] * q1[1]); w.w = pk2(v1[2] * q1[2], v1[3] * q1[3]);
                    *(u32x4*)(XG + (size_t)r * 1024 + c0) = w;
                    if (XG8) { u32x2 w8; w8.x = pk4_fp8(v0[0] * q0[0], v0[1] * q0[1], v0[2] * q0[2], v0[3] * q0[3]); w8.y = pk4_fp8(v1[0] * q1[0], v1[1] * q1[1], v1[2] * q1[2], v1[3] * q1[3]); *(u32x2*)(XG8 + (size_t)r * 1024 + c0) = w8; }
                }
            }
            ss += __shfl_xor(ss, 16); ss += __shfl_xor(ss, 32);
            if (fq == 0) rss[(size_t)(rss_global ? grow : r) * 16 + u.pn * 4 + wc] = ss;
        }
    }
};
struct EpiFF1 {
    bf16_t* H; const float* rss; const float* sw; int h; unsigned* done;
    __device__ __forceinline__ void operator()(const AccT& acc, const Unit& u, int wr, int wc, int fr, int fq) const {
        const bool fastb = u.pm < 32;
        const int colb = u.pn * 256 + wc * 32 + 8 * fq;
        f32x4 swv[2][2];
        if (fastb) { const float* swr = sw + (size_t)(4 * h + (u.pm >> 3)) * DFF + colb;
#pragma unroll
            for (int bj = 0; bj < 2; ++bj) { swv[bj][0] = *(const f32x4*)(swr + bj * 128); swv[bj][1] = *(const f32x4*)(swr + bj * 128 + 4); } }
        EPI_FOR_ROWS { const int r = EPI_R;
            const f32x4 q = *(const f32x4*)(rss + (size_t)r * 16 + 4 * fq);
            float ssum = (q[0] + q[1]) + (q[2] + q[3]); ssum += __shfl_xor(ssum, 16); ssum += __shfl_xor(ssum, 32);
            const float rstd = __builtin_amdgcn_rsqf(ssum * (1.f / 1024.f) + EPS);
            if (!fastb) { const float* swr = sw + (size_t)batch_of(grow_of(r, h)) * DFF + colb;
#pragma unroll
                for (int bj = 0; bj < 2; ++bj) { swv[bj][0] = *(const f32x4*)(swr + bj * 128); swv[bj][1] = *(const f32x4*)(swr + bj * 128 + 4); } }
            bf16_t* hr = H + (size_t)r * DFF + colb;
#pragma unroll
            for (int bj = 0; bj < 2; ++bj) {
                f32x4 v0 = acc[ai][bj][m][0] * rstd + swv[bj][0], v1 = acc[ai][bj][m][1] * rstd + swv[bj][1];
#pragma unroll
                for (int e = 0; e < 4; ++e) { const float a = fmaxf(v0[e], 0.f), c = fmaxf(v1[e], 0.f); v0[e] = a * a; v1[e] = c * c; }
                u32x4 w; w.x = pk2(v0[0], v0[1]); w.y = pk2(v0[2], v0[3]); w.z = pk2(v1[0], v1[1]); w.w = pk2(v1[2], v1[3]);
                *(u32x4*)(hr + bj * 128) = w;
            }
        }
        if (done) {
            asm volatile("s_waitcnt vmcnt(0)" ::: "memory");
            __builtin_amdgcn_s_barrier();
            if (wr == 0 && wc == 0) {
                __builtin_amdgcn_fence(__ATOMIC_RELEASE, "agent");
                asm volatile("s_waitcnt vmcnt(0)" ::: "memory");
                if ((fq * 16 + fr) == 0) (void)xb_add(done, 1u);
            }
        }
    }
};

#define TR_LOAD(tv, W_, ldw_, k0_, n0_) do { _Pragma("unroll") for (int _i = 0; _i < 8; ++_i) tv[_i] = *(const f32x4*)((W_) + (size_t)((k0_) + 8 * _i + (lane >> 3)) * (ldw_) + (n0_) + (lane & 7) * 4); } while (0)
__device__ __forceinline__ void tr_store(const f32x4 (&tv)[8], bf16_t* WT, int ldt, int k0, int n0, float* scr, int lane, int ncopy, int copy_stride) {
#pragma unroll
    for (int i = 0; i < 8; ++i) { float* d = scr + (8 * i + (lane >> 3)) * 33 + (lane & 7) * 4; d[0] = tv[i][0]; d[1] = tv[i][1]; d[2] = tv[i][2]; d[3] = tv[i][3]; }
    LDS_WAIT();
    const int c = lane & 7;
#pragma unroll
    for (int j = 0; j < 4; ++j) { const int n = (lane >> 3) + 8 * j; const float* s = scr + (8 * c) * 33 + n;
        u32x4 o; o.x = pk2(s[0], s[33]); o.y = pk2(s[66], s[99]); o.z = pk2(s[132], s[165]); o.w = pk2(s[198], s[231]);
        for (int cp = 0; cp < ncopy; ++cp) *(u32x4*)(WT + (size_t)(n0 + n) * ldt + (size_t)cp * copy_stride + k0 + 8 * c) = o; }
    LDS_WAIT();
}
__device__ __forceinline__ void tr_item(const float* W, int ldw, bf16_t* WT, int ldt, int k0, int n0, float* scr, int lane, int ncopy, int copy_stride) {
    f32x4 tv[8];
    TR_LOAD(tv, W, ldw, k0, n0);
    tr_store(tv, WT, ldt, k0, n0, scr, lane, ncopy, copy_stride);
}
__device__ __forceinline__ void tr_job(const float* W, int K, int N, bf16_t* WT, int ldt, int ncopy, int copy_stride, int gw, int NGW, float* scr, int lane, int ldw = 0) {
    if (ldw == 0) ldw = N;
    const int nblk = N / 32, items = (K / 64) * nblk;
    f32x4 ta[8], tb[8];
    int it = gw; bool ha = it < items;
    if (ha) TR_LOAD(ta, W, ldw, (it / nblk) * 64, (it % nblk) * 32);
    for (;;) {
        const int itb = it + NGW; const bool hb = itb < items;
        if (hb) TR_LOAD(tb, W, ldw, (itb / nblk) * 64, (itb % nblk) * 32);
        if (!ha) break;
        tr_store(ta, WT, ldt, (it / nblk) * 64, (it % nblk) * 32, scr, lane, ncopy, copy_stride);
        it = itb + NGW; ha = it < items;
        if (ha) TR_LOAD(ta, W, ldw, (it / nblk) * 64, (it % nblk) * 32);
        if (!hb) break;
        tr_store(tb, WT, ldt, (itb / nblk) * 64, (itb % nblk) * 32, scr, lane, ncopy, copy_stride);
    }
}
__device__ __forceinline__ void p0_convert(KP p, unsigned char* smem, int part, int wblk, int nblk) {
    const int tid = opaque_tid(), lane = tid & 63, wave = tid >> 6;
    const int gw = wblk * 8 + wave, NGW = nblk * 8;
    float* scr = (float*)(smem + wave * 8448);
    unsigned char* ws = p->ws;
    const int gt = wblk * 512 + tid, NGT = nblk * 512;
    if (part == 0) {
        for (int l = 0; l < 2; ++l) tr_job(p->in[7] + (size_t)l * 1024 * 6144, 1024, 6144, (bf16_t*)(ws + WS_Z) + (size_t)l * 6144 * 1024, 1024, 1, 0, (gw + 832 * l) % NGW, NGW, scr, lane);
        for (int i = gt; i < 256 * 1024 / 8; i += NGT) {
            const int row = i >> 7, k = (i & 127) * 8;
            u32x4 o = {0u, 0u, 0u, 0u};
            if (row < NBATCH) {
                const float* c = row < 8 ? p->in[2] + (size_t)row * 1024 + k : p->in[3] + (size_t)(row - 8) * 1024 + k;
                float f[8];
#pragma unroll
                for (int e = 0; e < 8; ++e) { const float v = c[e]; f[e] = v * sigm(v); }
                o = pack8(f);
            }
            *(u32x4*)((bf16_t*)(ws + WS_CA) + (size_t)row * 1024 + k) = o;
        }
        return;
    }
    for (int l = 0; l < 2; ++l) {
        tr_job(p->in[12] + (size_t)l * 1024 * INC, 1024, 6144, (bf16_t*)(ws + WS_WIN) + (size_t)l * 6144 * 1024, 1024, 1, 0, gw, NGW, scr, lane, INC);
        {
            const float* Wg = p->in[12] + (size_t)l * 1024 * INC + 6144;
            bf16_t* Tb = (bf16_t*)(ws + WS_Z + ZT_GATE) + (size_t)l * 3072 * 1024; unsigned char* T8 = ws + WS_W8 + (size_t)l * 3072 * 1024;
            for (int it = (gw + 700) % NGW; it < 16 * 96; it += NGW) {
                const int k0 = (it / 96) * 64, n0 = (it % 96) * 32;
                f32x4 tv[8];
                TR_LOAD(tv, Wg, INC, k0, n0);
#pragma unroll
                for (int i = 0; i < 8; ++i) { float* d = scr + (8 * i + (lane >> 3)) * 33 + (lane & 7) * 4; d[0] = tv[i][0]; d[1] = tv[i][1]; d[2] = tv[i][2]; d[3] = tv[i][3]; }
                LDS_WAIT();
                { const int c = lane & 7;
#pragma unroll
                  for (int j = 0; j < 4; ++j) { const int n = (lane >> 3) + 8 * j; const float* q = scr + (8 * c) * 33 + n;
                      u32x4 o; o.x = pk2(q[0], q[33]); o.y = pk2(q[66], q[99]); o.z = pk2(q[132], q[165]); o.w = pk2(q[198], q[231]);
                      *(u32x4*)(Tb + (size_t)(n0 + n) * 1024 + k0 + 8 * c) = o; } }
                { const int c = lane & 3;
#pragma unroll
                  for (int j = 0; j < 2; ++j) { const int n = (lane >> 2) + 16 * j; const float* q = scr + (16 * c) * 33 + n;
                      u32x4 o;
                      o.x = pk4_fp8(64.f * q[0], 64.f * q[33], 64.f * q[66], 64.f * q[99]); o.y = pk4_fp8(64.f * q[132], 64.f * q[165], 64.f * q[198], 64.f * q[231]);
                      o.z = pk4_fp8(64.f * q[264], 64.f * q[297], 64.f * q[330], 64.f * q[363]); o.w = pk4_fp8(64.f * q[396], 64.f * q[429], 64.f * q[462], 64.f * q[495]);
                      *(u32x4*)(T8 + (size_t)(n0 + n) * 1024 + k0 + 16 * c) = o; } }
                LDS_WAIT();
            }
        }
        tr_job(p->in[29] + (size_t)l * 1024 * DFF, 1024, DFF, (bf16_t*)(ws + WS_WF1) + (size_t)l * DFF * 1024, 1024, 1, 0, (gw + 1024) % NGW, NGW, scr, lane);
        tr_job(p->in[30] + (size_t)l * DFF * 1024, DFF, 1024, (bf16_t*)(ws + WS_WF2) + (size_t)l * 1024 * DFF, DFF, 1, 0, gw, NGW, scr, lane);
        for (int br = 0; br < 3; ++br)
            tr_job(p->in[25 + br] + (size_t)l * 1024 * 1024, 1024, 1024, (bf16_t*)(ws + WS_WBR) + ((size_t)l * 3 + br) * 1024 * 1024, 1024, 1, 0, (gw + 512 * br) % NGW, NGW, scr, lane);
        tr_job(p->in[28] + (size_t)l * 1024 * 1024, 1024, 1024, (bf16_t*)(ws + WS_WO3) + (size_t)l * 1024 * 1024, 1024, 1, 0, (gw + 1536) % NGW, NGW, scr, lane);
    }
    for (int job = gw; job < 128; job += NGW) {
        const int nb = job & 1, mat = (job >> 1) & 1, lh = job >> 2;
        const float* W = p->in[mat ? 17 : 15] + (size_t)lh * 4096;
        tr_item(W, 64, (bf16_t*)(ws + WS_LRUW) + (size_t)lh * 8192 + mat * 4096, 64, 0, nb * 32, scr, lane, 1, 0);
    }
    for (int i = gt; i < 2 * 16 * 128 * 128 / 8; i += NGT) {
        const f32x4 a = *(const f32x4*)(p->in[22] + (size_t)i * 8), b = *(const f32x4*)(p->in[22] + (size_t)i * 8 + 4);
        u32x4 o; o.x = pk2(a[0], a[1]); o.y = pk2(a[2], a[3]); o.z = pk2(b[0], b[1]); o.w = pk2(b[2], b[3]);
        *(u32x4*)((bf16_t*)(ws + WS_CMW) + (size_t)i * 8) = o;
    }
}
__device__ __forceinline__ void xg0_pass(KP p, int h, int wblk, int nblk) {
    const int tid_ = opaque_tid(), lane = tid_ & 63, gw = wblk * 8 + (tid_ >> 6), NGW = nblk * 8;
    const float* G1 = (const float*)(p->ws + WS_GB);
    bf16_t* XG = (bf16_t*)(p->ws + WS_XG); float* rsa = (float*)(p->ws + WS_RSA);
    for (int r = gw; r < MH; r += NGW) {
        const int grow = grow_of(r, h), b = batch_of(grow);
        const float* xr = grow < 16384 ? p->in[0] + (size_t)grow * 1024 : p->in[1] + (size_t)(grow - 16384) * 1024;
        const float* g = G1 + (size_t)b * 1024;
        float ss = 0.f;
#pragma unroll
        for (int j = 0; j < 4; ++j) {
            const int c = lane * 4 + 256 * j;
            const f32x4 v = *(const f32x4*)(xr + c), q = *(const f32x4*)(g + c);
            ss += (v[0] * v[0] + v[1] * v[1]) + (v[2] * v[2] + v[3] * v[3]);
            u32x2 w; w.x = pk2(v[0] * q[0], v[1] * q[1]); w.y = pk2(v[2] * q[2], v[3] * q[3]);
            *(u32x2*)(XG + (size_t)r * 1024 + c) = w;
            *(unsigned*)(p->ws + WS_XG8 + (size_t)r * 1024 + c) = pk4_fp8(v[0] * q[0], v[1] * q[1], v[2] * q[2], v[3] * q[3]);
        }
        ss = wave_sum(ss);
        if (lane < 16) rsa[(size_t)r * 16 + lane] = lane == 0 ? ss : 0.f;
    }
}
__device__ __forceinline__ void final_pass(KP p) {
    const int tid_ = opaque_tid(), lane = tid_ & 63, gw = blockIdx.x * 8 + (tid_ >> 6), NGW = gridDim.x * 8;
    const float* rsf = (const float*)(p->ws + WS_RSF); const float* gf = p->in[11];
    f32x4 q[4];
#pragma unroll
    for (int j = 0; j < 4; ++j) q[j] = *(const f32x4*)(gf + lane * 4 + 256 * j);
    for (int g0 = gw; g0 < MT; g0 += 2 * NGW) {
        f32x4 v[2][4]; float rs[2];
#pragma unroll
        for (int r = 0; r < 2; ++r) { const int grow = g0 + r * NGW; if (grow < MT) { rs[r] = sum16(rsf + (size_t)grow * 16);
#pragma unroll
            for (int j = 0; j < 4; ++j) v[r][j] = *(const f32x4*)(p->out + (size_t)grow * 1024 + lane * 4 + 256 * j); } }
#pragma unroll
        for (int r = 0; r < 2; ++r) { const int grow = g0 + r * NGW; if (grow < MT) { const float rstd = __builtin_amdgcn_rsqf(rs[r] * (1.f / 1024.f) + EPS);
#pragma unroll
            for (int j = 0; j < 4; ++j) *(f32x4*)(p->out + (size_t)grow * 1024 + lane * 4 + 256 * j) = v[r][j] * rstd * q[j]; } }
    }
}
__device__ __forceinline__ void sum_pass(KP p) {
    bf16_t* Z = (bf16_t*)(p->ws + WS_Z);
    const int gt = blockIdx.x * 512 + opaque_tid(), NGT = gridDim.x * 512;
    for (int i0 = gt; i0 < MH * 128; i0 += 4 * NGT) {
        u32x4 a[4], b[4], c[4];
#pragma unroll
        for (int j = 0; j < 4; ++j) { const int i = i0 + j * NGT; if (i < MH * 128) { const bf16_t* z = Z + (size_t)(i >> 7) * INC + 6144 + (i & 127) * 8; a[j] = *(const u32x4*)z; b[j] = *(const u32x4*)(z + 1024); c[j] = *(const u32x4*)(z + 2048); } }
#pragma unroll
        for (int j = 0; j < 4; ++j) { const int i = i0 + j * NGT; if (i < MH * 128) {
            float fa[8], fb[8], fc[8]; unpack8(a[j], fa); unpack8(b[j], fb); unpack8(c[j], fc);
#pragma unroll
            for (int e = 0; e < 8; ++e) fa[e] = (fa[e] + fb[e]) + fc[e];
            *(u32x4*)(Z + (size_t)(i >> 7) * INC + 6144 + (i & 127) * 8) = pack8(fa); } }
    }
}
__device__ __forceinline__ void ln_from_partials(const float* vs, float& mean, float& rstd) {
    float s = 0.f, q = 0.f;
#pragma unroll
    for (int i = 0; i < 8; ++i) { const f32x4 v = *(const f32x4*)(vs + 4 * i); s += v[0] + v[2]; q += v[1] + v[3]; }
    mean = s * (1.f / 1024.f);
    const float var = fmaxf(q * (1.f / 1024.f) - mean * mean, 0.f);
    rstd = __builtin_amdgcn_rsqf(var + EPS);
}
__device__ __forceinline__ void mixC_item(KP p, int l, int h, int item) {
    bf16_t* Z = (bf16_t*)(p->ws + WS_Z);
    const int tid = opaque_tid(), ch0 = (tid & 127) * 8, sub = tid >> 7, r0 = item * 32 + sub * 8;
    const bool prompt = r0 < 8192;
    const bool halo = prompt && (r0 & 2047) != 0;
    u32x4 gbw[8], gcw[8], xcw[8], hg[2], hx[2];
#pragma unroll
    for (int i = 0; i < 8; ++i) { const bf16_t* zr = Z + (size_t)(r0 + i) * INC + ch0; gbw[i] = *(const u32x4*)(zr + 3072); gcw[i] = *(const u32x4*)(zr + 4096); xcw[i] = *(const u32x4*)(zr + 5120); }
    float q1[8], q2[8];
    int js = 0;
    if (halo) {
#pragma unroll
        for (int i = 0; i < 2; ++i) { const bf16_t* zr = Z + (size_t)(r0 - 1 - i) * INC + ch0; hg[i] = *(const u32x4*)(zr + 4096); hx[i] = *(const u32x4*)(zr + 5120); }
        float a[8], b[8];
        unpack8(hg[0], a); unpack8(hx[0], b);
#pragma unroll
        for (int e = 0; e < 8; ++e) q1[e] = a[e] * b[e];
        unpack8(hg[1], a); unpack8(hx[1], b);
#pragma unroll
        for (int e = 0; e < 8; ++e) q2[e] = a[e] * b[e];
    } else if (!prompt) {
        js = 64 * h + ((r0 - 8192) >> 3);
        const float* st = p->in[6] + ((size_t)(l * 128 + js) * 2) * 1024 + ch0;
        const f32x4 a0 = *(const f32x4*)st, a1 = *(const f32x4*)(st + 4), b0 = *(const f32x4*)(st + 1024), b1 = *(const f32x4*)(st + 1028);
#pragma unroll
        for (int e = 0; e < 4; ++e) { q2[e] = a0[e]; q2[4 + e] = a1[e]; q1[e] = b0[e]; q1[4 + e] = b1[e]; }
    } else {
#pragma unroll
        for (int e = 0; e < 8; ++e) { q1[e] = 0.f; q2[e] = 0.f; }
    }
    const float* w = p->in[24] + (size_t)l * 3 * 1024 + ch0;
    float w0[8], w1[8], w2[8];
    { const f32x4 a = *(const f32x4*)w, b = *(const f32x4*)(w + 4), c = *(const f32x4*)(w + 1024), d = *(const f32x4*)(w + 1028), e2 = *(const f32x4*)(w + 2048), f = *(const f32x4*)(w + 2052);
#pragma unroll
      for (int e = 0; e < 4; ++e) { w0[e] = a[e]; w0[4 + e] = b[e]; w1[e] = c[e]; w1[4 + e] = d[e]; w2[e] = e2[e]; w2[4 + e] = f[e]; } }
#pragma unroll
    for (int i = 0; i < 8; ++i) {
        float gbv[8], gcv[8], xcv[8], y[8];
        unpack8(gbw[i], gbv); unpack8(gcw[i], gcv); unpack8(xcw[i], xcv);
#pragma unroll
        for (int e = 0; e < 8; ++e) { const float q = gcv[e] * xcv[e]; y[e] = gbv[e] * (w0[e] * q2[e] + w1[e] * q1[e] + w2[e] * q); q2[e] = q1[e]; q1[e] = q; }
        *(u32x4*)(Z + (size_t)(r0 + i) * INC + 2048 + ch0) = pack8(y);
    }
    float* o = nullptr;
    if (prompt) { if (((r0 + 7) & 2047) == 2047) o = p->out + O_SCP + ((size_t)(l * 8 + 4 * h + (r0 >> 11)) * 2) * 1024 + ch0; }
    else o = p->out + O_SCS + ((size_t)(l * 128 + js) * 2) * 1024 + ch0;
    if (o) {
        *(f32x4*)o = (f32x4){q2[0], q2[1], q2[2], q2[3]}; *(f32x4*)(o + 4) = (f32x4){q2[4], q2[5], q2[6], q2[7]};
        *(f32x4*)(o + 1024) = (f32x4){q1[0], q1[1], q1[2], q1[3]}; *(f32x4*)(o + 1028) = (f32x4){q1[4], q1[5], q1[6], q1[7]};
    }
}
__device__ __forceinline__ void mixB_prompt_item(KP p, int l, int item, unsigned char* smem) {
    bf16_t* Z = (bf16_t*)(p->ws + WS_Z);
    const int tid = opaque_tid(), lane = tid & 63, wid = tid >> 6, fr = lane & 15, fq = lane >> 4;
    const int chunk = item >> 2, cb = item & 3;
    const int r0 = (chunk >> 4) * 2048 + (chunk & 15) * 128;
    float* st = (float*)smem; unsigned* vnT = (unsigned*)(smem + 1024);
    const float* lng = p->in[20] + (size_t)l * 1024 + cb * 256; const float* lnb = p->in[21] + (size_t)l * 1024 + cb * 256;
    const bf16_t* CW = (const bf16_t*)(p->ws + WS_CMW) + (size_t)l * 16 * 128 * 128;
    const float* bs = p->in[23] + (size_t)l * 16 * 128;
    u32x4 va[4], vb[4];
#pragma unroll
    for (int i = 0; i < 4; ++i) { const bf16_t* vr = Z + (size_t)(r0 + 2 * lane) * INC + 2048 + cb * 256 + (wid * 4 + i) * 8; va[i] = *(const u32x4*)vr; vb[i] = *(const u32x4*)(vr + INC); }
    if (tid < 128) { float mean, rstd; ln_from_partials((const float*)(p->ws + WS_VS) + (size_t)(r0 + tid) * 32, mean, rstd); st[tid * 2] = mean; st[tid * 2 + 1] = rstd; }
    __syncthreads();
    {
        const f32x4 sm = *(const f32x4*)(st + 4 * lane);
#pragma unroll
        for (int i = 0; i < 4; ++i) {
            const int chl0 = (wid * 4 + i) * 8;
            const f32x4 g0 = *(const f32x4*)(lng + chl0), g1 = *(const f32x4*)(lng + chl0 + 4), b0 = *(const f32x4*)(lnb + chl0), b1 = *(const f32x4*)(lnb + chl0 + 4);
            float fa[8], fb[8]; unpack8(va[i], fa); unpack8(vb[i], fb);
#pragma unroll
            for (int e = 0; e < 8; ++e) {
                const float gg = e < 4 ? g0[e & 3] : g1[e & 3], bb = e < 4 ? b0[e & 3] : b1[e & 3];
                vnT[(chl0 + e) * 68 + lane] = pk2((fa[e] - sm[0]) * sm[1] * gg + bb, (fb[e] - sm[2]) * sm[3] * gg + bb);
            }
        }
    }
    __syncthreads();
    const int gl = wid >> 1, th = wid & 1, gg = cb * 4 + gl;
    bf16x8 Bf[4][4];
    u32x2 uw[4][4];
#pragma unroll
    for (int ks = 0; ks < 4; ++ks)
#pragma unroll
        for (int ni = 0; ni < 4; ++ni) {
            if (ks * 32 <= 64 * th + 16 * ni + 15) Bf[ks][ni] = *(const bf16x8*)(CW + ((size_t)gg * 128 + 64 * th + 16 * ni + fr) * 128 + ks * 32 + fq * 8);
        }
#pragma unroll
    for (int ni = 0; ni < 4; ++ni)
#pragma unroll
        for (int mi = 0; mi < 4; ++mi) uw[mi][ni] = *(const u32x2*)(Z + (size_t)(r0 + 64 * th + 16 * ni + fr) * INC + 1024 + cb * 256 + gl * 64 + mi * 16 + 4 * fq);
    f32x4 acc[4][4];
#pragma unroll
    for (int a = 0; a < 4; ++a)
#pragma unroll
        for (int b = 0; b < 4; ++b) acc[a][b] = (f32x4){0.f, 0.f, 0.f, 0.f};
#pragma unroll
    for (int ks = 0; ks < 4; ++ks) {
        if (ks * 32 <= 64 * th + 63) {
            bf16x8 A[4];
#pragma unroll
            for (int mi = 0; mi < 4; ++mi) A[mi] = *(const bf16x8*)((const bf16_t*)vnT + (gl * 64 + mi * 16 + fr) * 136 + ks * 32 + fq * 8);
#pragma unroll
            for (int ni = 0; ni < 4; ++ni) {
                if (ks * 32 <= 64 * th + 16 * ni + 15) {
                    const int t = 64 * th + 16 * ni + fr, s0 = ks * 32 + fq * 8;
                    bf16x8 B = Bf[ks][ni];
#pragma unroll
                    for (int e = 0; e < 8; ++e) if (s0 + e > t) B[e] = 0;
#pragma unroll
                    for (int mi = 0; mi < 4; ++mi) acc[mi][ni] = __builtin_amdgcn_mfma_f32_16x16x32_bf16(A[mi], B, acc[mi][ni], 0, 0, 0);
                }
            }
        }
    }
#pragma unroll
    for (int ni = 0; ni < 4; ++ni) {
        const int t = 64 * th + 16 * ni + fr;
        const float bsv = bs[gg * 128 + t];
#pragma unroll
        for (int mi = 0; mi < 4; ++mi) {
            const u32x2 w = uw[mi][ni];
            u32x2 o; o.x = pk2(lo_f(w.x) * (acc[mi][ni][0] + bsv), hi_f(w.x) * (acc[mi][ni][1] + bsv)); o.y = pk2(lo_f(w.y) * (acc[mi][ni][2] + bsv), hi_f(w.y) * (acc[mi][ni][3] + bsv));
            *(u32x2*)(Z + (size_t)(r0 + t) * INC + 1024 + cb * 256 + gl * 64 + mi * 16 + 4 * fq) = o;
        }
    }
    __syncthreads();
}
__device__ __forceinline__ void mixB_sample_item(KP p, int l, int h, int item) {
    bf16_t* Z = (bf16_t*)(p->ws + WS_Z);
    const int tid = opaque_tid(), lane = tid & 63, wid = tid >> 6;
    const int unit = item * 8 + wid, j = unit >> 1, hf = unit & 1, js = 64 * h + j, rb = 8192 + j * 8;
    const int ch0 = hf * 512 + lane * 8, g = ch0 >> 6;
    u32x4 vw[8], uw[8];
#pragma unroll
    for (int t = 0; t < 8; ++t) { const bf16_t* zr = Z + (size_t)(rb + t) * INC + ch0; vw[t] = *(const u32x4*)(zr + 2048); uw[t] = *(const u32x4*)(zr + 1024); }
    float mean, rstd;
    ln_from_partials((const float*)(p->ws + WS_VS) + (size_t)(rb + (lane & 7)) * 32, mean, rstd);
    const float* lng = p->in[20] + (size_t)l * 1024 + ch0; const float* lnb = p->in[21] + (size_t)l * 1024 + ch0;
    float gv[8], bv[8];
    { const f32x4 a = *(const f32x4*)lng, b = *(const f32x4*)(lng + 4), c = *(const f32x4*)lnb, d = *(const f32x4*)(lnb + 4);
#pragma unroll
      for (int e = 0; e < 4; ++e) { gv[e] = a[e]; gv[4 + e] = b[e]; bv[e] = c[e]; bv[4 + e] = d[e]; } }
    float vn[8][8];
#pragma unroll
    for (int t = 0; t < 8; ++t) {
        const float mt = __shfl(mean, t), rt = __shfl(rstd, t);
        float f[8]; unpack8(vw[t], f);
#pragma unroll
        for (int e = 0; e < 8; ++e) vn[t][e] = (f[e] - mt) * rt * gv[e] + bv[e];
        float* o = p->out + O_VS + ((size_t)(l * 128 + js) * 8 + t) * 1024 + ch0;
        *(f32x4*)o = (f32x4){vn[t][0], vn[t][1], vn[t][2], vn[t][3]}; *(f32x4*)(o + 4) = (f32x4){vn[t][4], vn[t][5], vn[t][6], vn[t][7]};
    }
    const float* W = p->in[22] + ((size_t)l * 16 + g) * 128 * 128; const float* bs = p->in[23] + ((size_t)l * 16 + g) * 128;
#pragma unroll
    for (int t = 0; t < 8; ++t) {
        float o[8]; const float b0 = bs[t];
#pragma unroll
        for (int e = 0; e < 8; ++e) o[e] = b0;
#pragma unroll
        for (int s = 0; s <= t; ++s) { const float ww = W[t * 128 + s];
#pragma unroll
            for (int e = 0; e < 8; ++e) o[e] += ww * vn[s][e]; }
        float uf[8]; unpack8(uw[t], uf);
#pragma unroll
        for (int e = 0; e < 8; ++e) o[e] *= uf[e];
        *(u32x4*)(Z + (size_t)(rb + t) * INC + 1024 + ch0) = pack8(o);
    }
}
__device__ __forceinline__ void lru_item(KP p, int l, int h, int pass, int sample, int idx, unsigned char* smem, int slot) {
    bf16_t* Z = (bf16_t*)(p->ws + WS_Z);
    const int tid = opaque_tid(), lane = tid & 63, wid = tid >> 6, fr = lane & 15, fq = lane >> 4;
    const int hb = idx & 3;
    int s = 0, tt = 0, grp = 0, r0;
    if (!sample) { s = idx >> 7; tt = (idx >> 2) & 31; r0 = s * 2048 + tt * 64; }
    else { grp = idx >> 2; r0 = 8192 + grp * 64; }
    bf16_t* xcb = (bf16_t*)(smem + (sample ? 0 : slot * 65536));
    f32x2* AB = (f32x2*)smem;
    unsigned* AP = (unsigned*)(smem + slot * 65536);
    const int hl = wid >> 1, mb = 32 * (wid & 1), hg = hb * 4 + hl;
    const bf16_t* WT = (const bf16_t*)(p->ws + WS_LRUW) + (size_t)(l * 16 + hg) * 128 * 64;
    bf16x8 Bf[8][2];
#pragma unroll
    for (int ni = 0; ni < 8; ++ni)
#pragma unroll
        for (int ks = 0; ks < 2; ++ks) Bf[ni][ks] = *(const bf16x8*)(WT + (size_t)(ni * 16 + fr) * 64 + ks * 32 + fq * 8);
    float lamv[4], bav[4], bxv[4];
#pragma unroll
    for (int ni = 0; ni < 4; ++ni) { const int ch = l * 1024 + hb * 256 + hl * 64 + ni * 16 + fr; lamv[ni] = p->in[19][ch]; bav[ni] = p->in[16][ch]; bxv[ni] = p->in[18][ch]; }
    {
        const int cgp = tid & 31, rq = tid >> 5, ch = hb * 256 + cgp * 8;
        float rows[7][8];
        u32x4 rw[7];
        if (!sample) {
#pragma unroll
            for (int i = 0; i < 7; ++i) {
                const int lr = 4 * rq - 3 + i;
                if (lr >= 0) rw[i] = *(const u32x4*)(Z + (size_t)(r0 + lr) * INC + ch);
                else if (tt == 0) rw[i] = (u32x4){0u, 0u, 0u, 0u};
                else rw[i] = *(const u32x4*)(Z + (size_t)(r0 + lr) * INC + ch);
            }
#pragma unroll
            for (int i = 0; i < 7; ++i) unpack8(rw[i], rows[i]);
        } else {
            const int j = rq >> 1, tb = (rq & 1) * 4;
#pragma unroll
            for (int i = 0; i < 7; ++i) { const int tp = tb - 3 + i; rw[i] = tp >= 0 ? *(const u32x4*)(Z + (size_t)(r0 + j * 8 + tp) * INC + ch) : (u32x4){0u, 0u, 0u, 0u}; }
#pragma unroll
            for (int i = 0; i < 7; ++i) unpack8(rw[i], rows[i]);
            if (tb == 0) {
                const float* sp = p->in[5] + ((size_t)(l * 128 + 64 * h + grp * 8 + j) * 3) * 1024 + ch;
#pragma unroll
                for (int i = 0; i < 3; ++i) { const f32x4 a = *(const f32x4*)(sp + i * 1024), b = *(const f32x4*)(sp + i * 1024 + 4);
#pragma unroll
                    for (int e = 0; e < 4; ++e) { rows[i][e] = a[e]; rows[i][4 + e] = b[e]; } }
            }
        }
        const float* cw = p->in[13] + (size_t)l * 4 * 1024 + ch; const float* cbias = p->in[14] + (size_t)l * 1024 + ch;
        float wk[4][8], bz[8];
#pragma unroll
        for (int k = 0; k < 4; ++k) { const f32x4 a = *(const f32x4*)(cw + k * 1024), b = *(const f32x4*)(cw + k * 1024 + 4);
#pragma unroll
            for (int e = 0; e < 4; ++e) { wk[k][e] = a[e]; wk[k][4 + e] = b[e]; } }
        { const f32x4 a = *(const f32x4*)cbias, b = *(const f32x4*)(cbias + 4);
#pragma unroll
          for (int e = 0; e < 4; ++e) { bz[e] = a[e]; bz[4 + e] = b[e]; } }
#pragma unroll
        for (int o = 0; o < 4; ++o) {
            float a8[8];
#pragma unroll
            for (int e = 0; e < 8; ++e) a8[e] = bz[e] + wk[0][e] * rows[o][e] + wk[1][e] * rows[o + 1][e] + wk[2][e] * rows[o + 2][e] + wk[3][e] * rows[o + 3][e];
            *(u32x4*)(xcb + (4 * rq + o) * 264 + cgp * 8) = pack8(a8);
        }
        {
            if (!sample) { if (tt == 31 && rq == 15) {
#pragma unroll
                for (int i = 0; i < 3; ++i) { float* o = p->out + O_LCP + ((size_t)(l * 8 + 4 * h + s) * 3 + i) * 1024 + ch;
                    *(f32x4*)o = (f32x4){rows[4 + i][0], rows[4 + i][1], rows[4 + i][2], rows[4 + i][3]}; *(f32x4*)(o + 4) = (f32x4){rows[4 + i][4], rows[4 + i][5], rows[4 + i][6], rows[4 + i][7]}; } } }
            else if (rq & 1) {
                const int js = 64 * h + grp * 8 + (rq >> 1);
#pragma unroll
                for (int i = 0; i < 3; ++i) { float* o = p->out + O_LCS + ((size_t)(l * 128 + js) * 3 + i) * 1024 + ch;
                    *(f32x4*)o = (f32x4){rows[4 + i][0], rows[4 + i][1], rows[4 + i][2], rows[4 + i][3]}; *(f32x4*)(o + 4) = (f32x4){rows[4 + i][4], rows[4 + i][5], rows[4 + i][6], rows[4 + i][7]}; }
            }
        }
    }
    __syncthreads();
    f32x4 acc[2][8];
#pragma unroll
    for (int a = 0; a < 2; ++a)
#pragma unroll
        for (int b = 0; b < 8; ++b) acc[a][b] = (f32x4){0.f, 0.f, 0.f, 0.f};
    bf16x8 Af[2][2];
#pragma unroll
    for (int mi = 0; mi < 2; ++mi)
#pragma unroll
        for (int ks = 0; ks < 2; ++ks) Af[mi][ks] = *(const bf16x8*)(xcb + (mb + mi * 16 + fr) * 264 + hl * 64 + ks * 32 + fq * 8);
#pragma unroll
    for (int ni = 0; ni < 8; ++ni)
#pragma unroll
        for (int ks = 0; ks < 2; ++ks)
#pragma unroll
            for (int mi = 0; mi < 2; ++mi) acc[mi][ni] = __builtin_amdgcn_mfma_f32_16x16x32_bf16(Af[mi][ks], Bf[ni][ks], acc[mi][ni], 0, 0, 0);
    float av[2][4][4], bv[2][4][4];
#pragma unroll
    for (int ni = 0; ni < 4; ++ni) {
        const int chl = hl * 64 + ni * 16 + fr;
        const float sp = 0.69314718f * __builtin_amdgcn_logf(1.f + __builtin_amdgcn_exp2f(-1.44269504f * lamv[ni]));
        const float ka = -8.f * 1.44269504f * sp, car_ = -1.44269504f * bav[ni], cxi = -1.44269504f * bxv[ni];
#pragma unroll
        for (int mi = 0; mi < 2; ++mi)
#pragma unroll
            for (int jj = 0; jj < 4; ++jj) {
                const int row = mb + mi * 16 + 4 * fq + jj;
                const float er = 1.f + __builtin_amdgcn_exp2f(fminf(-1.44269504f * acc[mi][ni][jj] + car_, 60.f));
                const float ei = 1.f + __builtin_amdgcn_exp2f(fminf(-1.44269504f * acc[mi][ni + 4][jj] + cxi, 60.f));
                const float inv = __builtin_amdgcn_rcpf(er * ei);
                const float rg = inv * ei, ig = inv * er;
                const float xv = bf2f(xcb[row * 264 + chl]);
                float tq = ka * rg;
                if (!sample) tq = (float)(_Float16)tq;
                const float a = __builtin_amdgcn_exp2f(tq);
                av[mi][ni][jj] = sample ? a : tq;
                bv[mi][ni][jj] = __builtin_amdgcn_sqrtf(fmaxf(1.f - a * a, 0.f)) * ig * xv;
            }
    }
    const int chs = hb * 256 + (tid & 255);
    float h0s[8];
    if (sample && tid < 256) {
#pragma unroll
        for (int j = 0; j < 8; ++j) h0s[j] = p->in[4][(size_t)(l * 128 + 64 * h + grp * 8 + j) * 1024 + chs];
    }
    __syncthreads();
#pragma unroll
    for (int ni = 0; ni < 4; ++ni)
#pragma unroll
        for (int mi = 0; mi < 2; ++mi)
#pragma unroll
            for (int jj = 0; jj < 4; ++jj) {
                const int e_ = (mb + mi * 16 + 4 * fq + jj) * 256 + hl * 64 + ni * 16 + fr;
                if (sample) AB[e_] = (f32x2){av[mi][ni][jj], bv[mi][ni][jj]};
                else { const _Float16 th = (_Float16)av[mi][ni][jj]; AP[e_] = (unsigned)__builtin_bit_cast(unsigned short, th) | (pk2(0.f, bv[mi][ni][jj]) & 0xffff0000u); }
            }
    __syncthreads();
    if (tid < 256) {
        if (!sample) {
            float hh = 0.f, P = 1.f;
#pragma unroll 16
            for (int row = 0; row < 64; ++row) { const unsigned w = AP[row * 256 + tid]; const float a = __builtin_amdgcn_exp2f((float)__builtin_bit_cast(_Float16, (unsigned short)(w & 0xffffu))); hh = a * hh + hi_f(w); P *= a; }
            *(f32x2*)((float*)(p->ws + WS_CAR) + ((size_t)(s * 32 + tt) * 1024 + chs) * 2) = (f32x2){P, hh};
        } else {
#pragma unroll
            for (int j = 0; j < 8; ++j) {
                float hh = h0s[j];
#pragma unroll
                for (int t = 0; t < 8; ++t) { const int row = j * 8 + t; const f32x2 ab = AB[row * 256 + tid]; hh = ab.x * hh + ab.y; AB[row * 256 + tid].x = hh; }
                p->out[O_HS + (size_t)(l * 128 + 64 * h + grp * 8 + j) * 1024 + chs] = hh;
            }
        }
    }
    __syncthreads();
    if (sample) {
#pragma unroll
        for (int i = 0; i < 8; ++i) {
            const int row = wid * 8 + i;
#pragma unroll
            for (int j = 0; j < 2; ++j) {
                const f32x4 v = *(const f32x4*)&AB[row * 256 + (lane + 64 * j) * 2];
                *(unsigned*)(Z + (size_t)(r0 + row) * INC + hb * 256 + (lane + 64 * j) * 2) = pk2(v[0], v[2]);
            }
        }
        __syncthreads();
    }
}

__device__ __forceinline__ void lru_finish(KP p, int l, int h, int idx, unsigned char* smem, int slot) {
    bf16_t* Z = (bf16_t*)(p->ws + WS_Z);
    const int tid = opaque_tid(), lane = tid & 63, wid = tid >> 6;
    const int hb = idx & 3, s = idx >> 7, tt = (idx >> 2) & 31, r0 = s * 2048 + tt * 64;
    unsigned* AP = (unsigned*)(smem + slot * 65536);
    if (tid < 256) {
        const int chs = hb * 256 + tid;
        const float* car = (const float*)(p->ws + WS_CAR);
        f32x2 cr[31];
#pragma unroll
        for (int k = 0; k < 31; ++k) if (k < tt) cr[k] = *(const f32x2*)(car + ((size_t)(s * 32 + k) * 1024 + chs) * 2);
        float hh = 0.f;
#pragma unroll
        for (int k = 0; k < 31; ++k) if (k < tt) hh = cr[k].x * hh + cr[k].y;
#pragma unroll 16
        for (int row = 0; row < 64; ++row) { const unsigned w = AP[row * 256 + tid]; const float a = __builtin_amdgcn_exp2f((float)__builtin_bit_cast(_Float16, (unsigned short)(w & 0xffffu))); hh = a * hh + hi_f(w); AP[row * 256 + tid] = __float_as_uint(hh); }
        if (tt == 31) p->out[O_HP + (size_t)(l * 8 + 4 * h + s) * 1024 + chs] = hh;
    }
    __syncthreads();
#pragma unroll
    for (int i = 0; i < 8; ++i) {
        const int row = wid * 8 + i;
        const f32x4 v = *(const f32x4*)(const void*)&AP[row * 256 + lane * 4];
        u32x2 o; o.x = pk2(v[0], v[1]); o.y = pk2(v[2], v[3]);
        *(u32x2*)(Z + (size_t)(r0 + row) * INC + hb * 256 + lane * 4) = o;
    }
    __syncthreads();
}

#ifndef PHM
#define PHM 0xFFFF
#endif
#ifndef NSYNC
#define NSYNC 1
#endif
#define GSYNC do { FRESH_P; XcdBarrier xb_; xb_.bar = (unsigned*)(p->ws + WS_BAR); xb_.x = xb_xcc_id(); xb_.st = (volatile LAS unsigned*)((LAS unsigned char*)smem + 131072); xcd_barrier(xb_); } while (0)
__global__ void __launch_bounds__(512) mega(Params p_unused) {
    cg::grid_group grid = cg::this_grid();
    extern __shared__ __attribute__((aligned(16))) unsigned char smem[];
    LAS unsigned char* lds = (LAS unsigned char*)smem;
    volatile LAS unsigned* xst = (volatile LAS unsigned*)(lds + 131072);
    if (threadIdx.x == 0) { xst[0] = 0u; xst[1] = 0u; }
    __syncthreads();
    { FRESH_P; (void)xcd_barrier_post((unsigned*)(p->ws + WS_BAR), xst); }

    if (PHM & 1) { FRESH_P; p0_convert(p, smem, 0, blockIdx.x, gridDim.x); }
    { FRESH_P; if (p->ws == nullptr) grid.sync(); }
    GSYNC;
    if (PHM & 3) {
        FRESH_P;
        if (blockIdx.x < 48) {
            unsigned char* ws = p->ws;
            pg8::Gemm g{(const bf16_t*)(ws + WS_CA), (const bf16_t*)(ws + WS_Z), 1024, 1024, 1024, 0, 0};
            pg8::Order S; S.init(1, 48, 1, gridDim.x, blockIdx.x, 16);
            EpiMod E{(float*)(ws + WS_MOD), p->in[8]};
            pg8::gemm_phase(lds, g, S, E);
        } else p0_convert(p, smem, 1, blockIdx.x - 48, gridDim.x - 48);
    }
    GSYNC;
    if (PHM & 2) { FRESH_P; derive_pass(p, blockIdx.x, gridDim.x); }
    GSYNC;
    if (PHM & 4) {
        FRESH_P; unsigned char* ws = p->ws;
        const int G = gridDim.x, bid = blockIdx.x;
        int off = 0;
        for (int q = 0; q < 6; ++q) {
            const int l = q / 3, kind = q % 3, N = kind == 0 ? 6144 : (kind == 1 ? 3072 : DFF);
            const bf16_t* Bt = kind == 0 ? (const bf16_t*)(ws + WS_WIN) + (size_t)l * 6144 * 1024
                             : kind == 1 ? (const bf16_t*)(ws + WS_Z + ZT_GATE) + (size_t)l * 3072 * 1024 : (const bf16_t*)(ws + WS_WF1) + (size_t)l * DFF * 1024;
            pg8::Gemm g{(const bf16_t*)(ws + WS_SHA) + (size_t)(l * 2 + (kind == 2)) * 256 * 1024, Bt, 1024, 1024, 1024, 0, 0};
            pg8::Order S; S.init(1, N / 256, 1, G, (bid - off + G) % G, 16);
            EpiSW E{kind == 2 ? (float*)(ws + WS_SW2) + (size_t)l * NBATCH * DFF : (float*)(ws + WS_SW1) + (size_t)l * NBATCH * INC + (kind == 1 ? 6144 : 0), kind == 2 ? DFF : INC};
            pg8::gemm_phase(lds, g, S, E);
            off = (off + N / 256) % G;
        }
        if (bid >= 104) xg0_pass(p, 0, bid - 104, G - 104);
    }
    GSYNC;

    for (int hl = 0; hl < 4; ++hl) {
        int h = hl >> 1, l = hl & 1;
        asm volatile("" : "+s"(h), "+s"(l));
        if (PHM & 8) {
            FRESH_P; unsigned char* ws = p->ws;
            {
                pg8::Gemm g{(const bf16_t*)(ws + WS_XG), (const bf16_t*)(ws + WS_WIN) + (size_t)l * 6144 * 1024, 1024, 1024, 1024, 0, 0};
                pg8::Order S; S.init(34, 24, 1, gridDim.x, blockIdx.x, 16);
                EpiG1 E{(bf16_t*)(ws + WS_Z), (const float*)(ws + WS_RSA), (const float*)(ws + WS_SW1) + (size_t)l * NBATCH * INC, h, (float*)(ws + WS_VS), 0};
                pg8::gemm_phase(lds, g, S, E);
            }
            {
                pg8::Gemm g{(const bf16_t*)(ws + WS_XG8), (const bf16_t*)(ws + WS_W8) + (size_t)l * 3072 * 512, 512, 512, 512, 0, 0};
                pg8::Order S; S.init(34, 12, 1, (int)gridDim.x - 48, blockIdx.x >= 48 ? (int)blockIdx.x - 48 : (1 << 28), 8);
                EpiGate E{(bf16_t*)(ws + WS_Z), (const float*)(ws + WS_RSA), (const float*)(ws + WS_SW1) + (size_t)l * NBATCH * INC, h};
                pg8::gemm_phase<EpiGate, pg8::Order, true>(lds, g, S, E);
            }
        }
        GSYNC;
        if (PHM & 16) {
            FRESH_P;
            for (int it = blockIdx.x; it < 256 + 16; it += gridDim.x) {
                if (it < 256) mixB_prompt_item(p, l, it, smem);
                else mixB_sample_item(p, l, h, it - 256);
            }
#pragma unroll 1
            for (int slot = 0; slot < 2; ++slot) lru_item(p, l, h, 1, 0, blockIdx.x + 256 * slot, smem, slot);
        }
        GSYNC;
        if (PHM & 32) {
            FRESH_P;
#pragma unroll 1
            for (int slot = 0; slot < 2; ++slot) lru_finish(p, l, h, blockIdx.x + 256 * slot, smem, slot);
            if (blockIdx.x < 32) lru_item(p, l, h, 2, 1, blockIdx.x, smem, 0);
            else for (int it = blockIdx.x - 32; it < 272; it += gridDim.x - 32) mixC_item(p, l, h, it);
        }
        GSYNC;
        if (PHM & 64) {
            FRESH_P; unsigned char* ws = p->ws; bf16_t* Z = (bf16_t*)(ws + WS_Z);
            pg8::Gemm g{Z, (const bf16_t*)(ws + WS_WBR) + (size_t)l * 3 * 1024 * 1024, INC, 1024, 1024, 1024, (size_t)1024 * 1024};
            pg8::Order S; S.init(34, 4, 3, gridDim.x, blockIdx.x, 16);
            EpiBR E{Z};
            pg8::gemm_phase(lds, g, S, E);
        }
        GSYNC;
        if (PHM & 64) { FRESH_P; sum_pass(p); }
        GSYNC;
        if (PHM & 128) {
            FRESH_P; unsigned char* ws = p->ws;
            pg8::Gemm g{(const bf16_t*)(ws + WS_Z) + 6144, (const bf16_t*)(ws + WS_WO3) + (size_t)l * 1024 * 1024, INC, 1024, 1024, 0, 0};
            pg8::Order S; S.init(34, 4, 1, gridDim.x, blockIdx.x, 16);
            EpiRes<false> E{p->in[0], p->in[1], p->out, (const float*)(ws + WS_MOD) + l * 6144 + 2048, (const float*)(ws + WS_GB) + (size_t)(l * 2 + 1) * NBATCH * 1024,
                     (bf16_t*)(ws + WS_XG), (float*)(ws + WS_RSB), h, l == 0, 0, nullptr, nullptr, nullptr, 0};
            pg8::gemm_phase(lds, g, S, E);
        }
        GSYNC;
        if (PHM & 256) {
            FRESH_P; unsigned char* ws = p->ws;
            pg8::Gemm g{(const bf16_t*)(ws + WS_XG), (const bf16_t*)(ws + WS_WF1) + (size_t)l * DFF * 1024, 1024, 1024, 1024, 0, 0};
            pg8::Order S; S.init(32, 16, 1, gridDim.x, blockIdx.x, 16);
            EpiFF1 E{(bf16_t*)(ws + WS_Z), (const float*)(ws + WS_RSB), (const float*)(ws + WS_SW2) + (size_t)l * NBATCH * DFF, h, nullptr};
            pg8::gemm_phase(lds, g, S, E);
        }
        GSYNC;
        if (PHM & 512) {
            FRESH_P; unsigned char* ws = p->ws;
            unsigned* skf = (unsigned*)(ws + WS_BAR + 16384) + (h * 2 + l) * 256;
            unsigned* pdone = (unsigned*)(ws + WS_BAR + 16384 + 8192) + (h * 2 + l) * 64;
            if (blockIdx.x >= 224) {
                const int j = (int)blockIdx.x - 224;
                {
                    pg8::Gemm g{(const bf16_t*)(ws + WS_XG), (const bf16_t*)(ws + WS_WF1) + (size_t)l * DFF * 1024, 1024, 1024, 1024, 0, 0};
                    pg8::OrderOne S1{32 + (j >> 4), j & 15, 16};
                    EpiFF1 E{(bf16_t*)(ws + WS_Z), (const float*)(ws + WS_RSB), (const float*)(ws + WS_SW2) + (size_t)l * NBATCH * DFF, h, pdone + (j >> 4) * 32};
                    pg8::gemm_phase(lds, g, S1, E);
                }
                if (threadIdx.x < 64) {
                    unsigned sp = 0;
                    while (xb_ld(pdone + (j >> 4) * 32) < 16u) { __builtin_amdgcn_s_sleep(2); if (++sp > (1u << 22)) break; }
                    __builtin_amdgcn_fence(__ATOMIC_ACQUIRE, "agent");
                    asm volatile("s_waitcnt vmcnt(0)" ::: "memory");
                }
                __syncthreads();
            }
            pg8::Gemm g{(const bf16_t*)(ws + WS_Z), (const bf16_t*)(ws + WS_WF2) + (size_t)l * 1024 * DFF, DFF, DFF, DFF, 0, 0};
            pg8::OrderSK S; S.c = blockIdx.x;
            EpiRes<true> E{nullptr, nullptr, p->out, (const float*)(ws + WS_MOD) + l * 6144 + 5120, l == 0 ? (const float*)(ws + WS_GB) + (size_t)2 * NBATCH * 1024 : nullptr,
                     (bf16_t*)(ws + WS_XG), l == 0 ? (float*)(ws + WS_RSA) : (float*)(ws + WS_RSF), h, 0, l == 1, ws + WS_XG8,
                     (float*)(ws + WS_Z + (72ull << 20)), skf, (int)blockIdx.x};
            pg8::gemm_phase(lds, g, S, E);
            if (h == 0 && l == 1 && blockIdx.x < 224) xg0_pass(p, 1, blockIdx.x, 224);
        }
        GSYNC;
    }
    if (PHM & 1024) { FRESH_P; final_pass(p); }
}

extern "C" void kernel_launch(void* const* d_in, const int* in_sizes, int n_in, void* d_out, int out_size, void* d_ws, size_t ws_size, hipStream_t stream) {
    static int grid_blocks = 0;
    if (grid_blocks == 0) {
        if (n_in != 31 || ws_size < WS_END) { fprintf(stderr, "kernel_launch: need 31 inputs and %zu bytes of workspace, got %d / %zu\n", (size_t)WS_END, n_in, ws_size); grid_blocks = -1; return; }
        int dev = 0, cus = 0, per_cu = 0;
        hipGetDevice(&dev);
        hipDeviceGetAttribute(&cus, hipDeviceAttributeMultiprocessorCount, dev);
        hipFuncSetAttribute((const void*)mega, hipFuncAttributeMaxDynamicSharedMemorySize, LDS_BYTES);
        hipOccupancyMaxActiveBlocksPerMultiprocessor(&per_cu, (const void*)mega, 512, LDS_BYTES);
        if (per_cu < 1) { fprintf(stderr, "kernel_launch: occupancy query says %d blocks per CU\n", per_cu); per_cu = 1; }
        if (per_cu > 1) per_cu = 1;
        grid_blocks = cus * per_cu;
        if (grid_blocks != 256) { fprintf(stderr, "kernel_launch: built for a 256-CU device, got %d\n", grid_blocks); if (grid_blocks > 256) grid_blocks = 256; else { grid_blocks = -1; return; } }
    }
    if (grid_blocks < 0) return;
    Params p{};
    for (int i = 0; i < 31; ++i) p.in[i] = (const float*)d_in[i];
    p.out = (float*)d_out; p.ws = (unsigned char*)d_ws;
    if (hipMemsetAsync((unsigned char*)d_ws + WS_BAR, 0, 32768, stream) != hipSuccess) { fprintf(stderr, "kernel_launch: memset of the barrier words failed\n"); return; }
    void* args[] = {&p};
    hipError_t e = hipLaunchCooperativeKernel((const void*)mega, dim3(grid_blocks), dim3(512), args, LDS_BYTES, stream);
    if (e != hipSuccess) fprintf(stderr, "cooperative launch failed: %s (grid %d)\n", hipGetErrorString(e), grid_blocks);
}
```

```cpp
#include <hip/hip_runtime.h>
#include <hip/hip_cooperative_groups.h>
#include <cstdio>
#include <cstdint>
namespace cg = cooperative_groups;

#define LAS __attribute__((address_space(3)))
typedef unsigned short bf16_t;
typedef short bf16x8 __attribute__((ext_vector_type(8)));
typedef float f32x4 __attribute__((ext_vector_type(4)));
typedef float f32x2 __attribute__((ext_vector_type(2)));
typedef unsigned u32x4 __attribute__((ext_vector_type(4)));
typedef unsigned u32x2 __attribute__((ext_vector_type(2)));
typedef int i32x4 __attribute__((ext_vector_type(4)));
typedef int i32x8 __attribute__((ext_vector_type(8)));

constexpr int D = 1024, NBATCH = 136, MH = 8704, MT = 17408, INC = 9216, DFF = 4096;
constexpr float EPS = 1e-6f;
constexpr size_t O_YP = 0, O_HP = 17825792, O_LCP = O_HP + 16384, O_SCP = O_LCP + 49152, O_HS = O_SCP + 32768,
                 O_LCS = O_HS + 262144, O_SCS = O_LCS + 786432, O_VS = O_SCS + 524288;
constexpr size_t WS_WIN = 0;
constexpr size_t WS_WBR = WS_WIN + 2ull * 6144 * 1024 * 2;
constexpr size_t WS_WO3 = WS_WBR + 2ull * 3 * 1024 * 1024 * 2;
constexpr size_t WS_WF1 = WS_WO3 + 2ull * 1024 * 1024 * 2;
constexpr size_t WS_WF2 = WS_WF1 + 2ull * 4096 * 1024 * 2;
constexpr size_t WS_LRUW = WS_WF2 + 2ull * 1024 * 4096 * 2;
constexpr size_t WS_CMW = WS_LRUW + 2ull * 16 * 128 * 64 * 2;
constexpr size_t WS_CA = WS_CMW + 2ull * 16 * 128 * 128 * 2;
constexpr size_t WS_SHA = WS_CA + 256ull * 1024 * 2;
constexpr size_t WS_MOD = WS_SHA + 4ull * 256 * 1024 * 2;
constexpr size_t WS_GB = WS_MOD + 136ull * 12288 * 4;
constexpr size_t WS_SW1 = WS_GB + 4ull * 136 * 1024 * 4;
constexpr size_t WS_SW2 = WS_SW1 + 2ull * 136 * 9216 * 4;
constexpr size_t WS_RSA = WS_SW2 + 2ull * 136 * 4096 * 4;
constexpr size_t WS_RSB = WS_RSA + 8704ull * 16 * 4;
constexpr size_t WS_RSF = WS_RSB + 8704ull * 16 * 4;
constexpr size_t WS_CAR = WS_RSF + 17408ull * 16 * 4;
constexpr size_t WS_XG = WS_CAR + 4ull * 32 * 1024 * 2 * 4;
constexpr size_t WS_Z = WS_XG + 8704ull * 1024 * 2;
constexpr size_t WS_VS = WS_Z + 8704ull * 9216 * 2;
constexpr size_t WS_BAR = WS_VS + 8704ull * 32 * 4;
constexpr size_t WS_W8 = WS_BAR + 32768;
constexpr size_t WS_XG8 = WS_W8 + 2ull * 3072 * 1024;
constexpr size_t WS_END = WS_XG8 + 8704ull * 1024;
constexpr size_t ZT_GATE = 32ull << 20;
constexpr int LDS_BYTES = 131072 + 2048;

struct Params { const float* in[31]; float* out; unsigned char* ws; };
typedef const __attribute__((address_space(4))) Params* KP;
#define FRESH_P KP p = (KP)__builtin_amdgcn_kernarg_segment_ptr(); asm volatile("" : "+s"(p))
__device__ __forceinline__ int opaque_tid() { int t = threadIdx.x; asm volatile("" : "+v"(t)); return t; }

__device__ __forceinline__ float bf2f(bf16_t v) { return __uint_as_float(((unsigned)v) << 16); }
__device__ __forceinline__ unsigned pk2(float lo, float hi) { unsigned r; asm volatile("v_cvt_pk_bf16_f32 %0, %1, %2" : "=v"(r) : "v"(lo), "v"(hi)); return r; }
__device__ __forceinline__ float lo_f(unsigned w) { return __uint_as_float(w << 16); }
__device__ __forceinline__ float hi_f(unsigned w) { return __uint_as_float(w & 0xffff0000u); }
__device__ __forceinline__ void unpack8(u32x4 w, float* f) { f[0] = lo_f(w.x); f[1] = hi_f(w.x); f[2] = lo_f(w.y); f[3] = hi_f(w.y); f[4] = lo_f(w.z); f[5] = hi_f(w.z); f[6] = lo_f(w.w); f[7] = hi_f(w.w); }
__device__ __forceinline__ u32x4 pack8(const float* f) { u32x4 o; o.x = pk2(f[0], f[1]); o.y = pk2(f[2], f[3]); o.z = pk2(f[4], f[5]); o.w = pk2(f[6], f[7]); return o; }
__device__ __forceinline__ unsigned pk4_fp8(float a, float b, float c, float d) { int w = 0; w = __builtin_amdgcn_cvt_pk_fp8_f32(a, b, w, false); w = __builtin_amdgcn_cvt_pk_fp8_f32(c, d, w, true); return (unsigned)w; }
__device__ __forceinline__ float sigm(float v) { return __builtin_amdgcn_rcpf(1.f + __builtin_amdgcn_exp2f(-1.44269504f * v)); }
__device__ __forceinline__ float wave_sum(float v) {
#pragma unroll
    for (int o = 1; o < 64; o <<= 1) v += __shfl_xor(v, o);
    return v;
}
__device__ __forceinline__ float sum16(const float* p) {
    const f32x4 a = *(const f32x4*)p, b = *(const f32x4*)(p + 4), c = *(const f32x4*)(p + 8), d = *(const f32x4*)(p + 12);
    return (((a.x + a.y) + (a.z + a.w)) + ((b.x + b.y) + (b.z + b.w))) + (((c.x + c.y) + (c.z + c.w)) + ((d.x + d.y) + (d.z + d.w)));
}
__device__ __forceinline__ int grow_of(int r, int h) { return r < 8192 ? h * 8192 + r : 16384 + h * 512 + (r - 8192); }
__device__ __forceinline__ int batch_of(int grow) { return grow < 16384 ? (grow >> 11) : 8 + ((grow - 16384) >> 3); }
#define LDS_WAIT() asm volatile("s_waitcnt lgkmcnt(0)" ::: "memory")


#define XB_TMO      128
#define XB_XCNT(j)  (256  + 64 * (j))
#define XB_XSUB(j)  (1280 + 64 * (j))
#define XB_XGEN(j)  (2304 + 64 * (j))
#define XB_TOP      3328
#define XB_TOPGEN   3392
#define XCD_BAR_WORDS 3456
#define XB_SPIN_CAP (1u << 18)
__device__ __forceinline__ unsigned xb_ld(unsigned* p)              { return __hip_atomic_load(p, __ATOMIC_RELAXED, __HIP_MEMORY_SCOPE_AGENT); }
__device__ __forceinline__ unsigned xb_add(unsigned* p, unsigned v) { return __hip_atomic_fetch_add(p, v, __ATOMIC_RELAXED, __HIP_MEMORY_SCOPE_AGENT); }
__device__ __forceinline__ unsigned xb_xcc_id() { return (unsigned)__builtin_amdgcn_s_getreg((3 << 11) | 20) & 0xFu; }
#define XB_SPIN(cond, bar) do { unsigned _sp = 0; while (cond) { __builtin_amdgcn_s_sleep(1); \
    if ((++_sp & 255u) == 0u) { if (xb_ld(&(bar)[XB_TMO])) break; if (_sp > XB_SPIN_CAP) { atomicAdd(&(bar)[XB_TMO], 1u); break; } } } } while (0)
struct XcdBarrier { unsigned* bar; unsigned x; volatile LAS unsigned* st; };
__device__ __forceinline__ XcdBarrier xcd_barrier_post(unsigned* bar, volatile LAS unsigned* st) {
    XcdBarrier b; b.bar = bar; b.x = xb_xcc_id(); b.st = st;
    if (threadIdx.x == 0) (void)xb_add(&bar[XB_XCNT(b.x)], 1u);
    return b;
}
__device__ __forceinline__ void xcd_barrier_complete(unsigned* bar, unsigned x, unsigned& nloc, unsigned& nx) {
    const unsigned G = gridDim.x * gridDim.y * gridDim.z;
    unsigned sum, cnt, mine, sp = 0u;
    for (;;) {
        sum = 0u; cnt = 0u; mine = 0u;
#pragma unroll
        for (unsigned j = 0; j < 16; ++j) { const unsigned c = xb_ld(&bar[XB_XCNT(j)]); sum += c; cnt += (c > 0u) ? 1u : 0u; mine = (j == x) ? c : mine; }
        if (sum == G) break;
        __builtin_amdgcn_s_sleep(1);
        if ((++sp & 255u) == 0u) { if (xb_ld(&bar[XB_TMO])) break; if (sp > XB_SPIN_CAP) { atomicAdd(&bar[XB_TMO], 1u); break; } }
    }
    nloc = mine > 0u ? mine : 1u; nx = cnt > 0u ? cnt : 1u;
}
__device__ __forceinline__ void xcd_barrier(const XcdBarrier& b) {
    asm volatile("s_waitcnt vmcnt(0)" ::: "memory");
    __syncthreads();
    if (threadIdx.x == 0) {
        unsigned* bar = b.bar;
        __builtin_amdgcn_s_waitcnt(0);
        unsigned nloc = b.st[0], nx = b.st[1];
        if (nloc == 0u) { xcd_barrier_complete(bar, b.x, nloc, nx); b.st[0] = nloc; b.st[1] = nx; }
        const unsigned old = xb_add(&bar[XB_XSUB(b.x)], 1u);
        const unsigned gen = old / nloc;
        if (old + 1u == (gen + 1u) * nloc) {
            __builtin_amdgcn_fence(__ATOMIC_RELEASE, "agent");
            asm volatile("s_waitcnt vmcnt(0)" ::: "memory");
            const unsigned og = xb_add(&bar[XB_TOP], 1u);
            const unsigned tg = og / nx;
            if (og + 1u == (tg + 1u) * nx) xb_add(&bar[XB_TOPGEN], 1u);
            else XB_SPIN(xb_ld(&bar[XB_TOPGEN]) == tg, bar);
            __builtin_amdgcn_fence(__ATOMIC_ACQUIRE, "agent");
            xb_add(&bar[XB_XGEN(b.x)], 1u);
            asm volatile("s_waitcnt vmcnt(0)" ::: "memory");
        } else {
            XB_SPIN(xb_ld(&bar[XB_XGEN(b.x)]) == gen, bar);
            __builtin_amdgcn_fence(__ATOMIC_ACQUIRE, "agent");
            asm volatile("s_waitcnt vmcnt(0)" ::: "memory");
        }
    }
    __syncthreads();
}

namespace pg8 {
constexpr int BM = 256, BK = 64, HALF = 128, HTB = HALF * BK * 2, NXCD = 8, WGM = 8;
__device__ __forceinline__ int lds_byte(int r, int c) { const int st = (r >> 4) * 2 + (c >> 5), rr = r & 15, cc = c & 31, ob = rr * 64 + cc * 2; return st * 1024 + (ob ^ (((ob >> 9) & 1) << 5)); }
__device__ __forceinline__ void stage_rc(int b, int& R, int& C) { const int st = b / 1024, sb = b % 1024, swz = sb ^ (((sb >> 9) & 1) << 5); R = (st >> 1) * 16 + swz / 64; C = (st & 1) * 32 + (swz % 64) / 2; }
__device__ __forceinline__ int perm32(int rho) { const int n = rho >> 4, i = rho & 15; return 8 * (i >> 2) + 4 * n + (i & 3); }

struct Unit { int pm, pn, g, k0, nkt, role, np; };
struct Gemm { const bf16_t* A; const bf16_t* Bt; int lda, ldb, K; size_t a_gs, b_gs; };
struct Order {
    int nM, nN, nwg, ngrp, G, c, nt;
    __device__ __forceinline__ void init(int nM_, int nN_, int ngrp_, int G_, int c_, int nt_) { nM = nM_; nN = nN_; nwg = nM * nN; ngrp = ngrp_; G = G_; c = c_; nt = nt_; }
    __device__ __forceinline__ bool next(int i, Unit& u) const {
        const int L = i * G + c; if (L >= nwg * ngrp) return false;
        u.g = L / nwg; int wgid = L % nwg; u.k0 = 0; u.nkt = nt; u.role = 0; u.np = 0;
        { const int q = nwg / NXCD, r = nwg % NXCD, xcd = wgid % NXCD, off = wgid / NXCD; wgid = (xcd < r ? xcd * (q + 1) : r * (q + 1) + (xcd - r) * q) + off; }
        const int nig = WGM * nN, gid = wgid / nig, fm = gid * WGM, gsz = (nM - fm) < WGM ? (nM - fm) : WGM;
        u.pm = fm + ((wgid % nig) % gsz); u.pn = (wgid % nig) / gsz; return true;
    }
};
struct OrderSK {
    int c;
    static __device__ __forceinline__ int len_of(int b) { return b < 64 ? 38 : (b < 224 ? 36 : 16); }
    static __device__ __forceinline__ int beg_of(int b) { return b < 64 ? 38 * b : (b < 224 ? 2432 + 36 * (b - 64) : 8192 + 16 * (b - 224)); }
    __device__ __forceinline__ bool next(int i, Unit& u) const {
        const int beg = beg_of(c), len = len_of(c), T0 = beg >> 6, k0 = beg & 63, n0 = (64 - k0) < len ? (64 - k0) : len;
        int T, kk, n;
        if (i == 0) { T = T0; kk = k0; n = n0; }
        else if (i == 1 && n0 < len) { T = T0 + 1; kk = 0; n = len - n0; }
        else return false;
        u.pm = T >> 2; u.pn = T & 3; u.g = 0; u.k0 = kk; u.nkt = n;
        if (kk > 0) { u.role = 1; u.np = 0; }
        else { const int rem = 64 - n, l1 = len_of(c + 1), l2 = len_of(c + 2); u.role = 2; u.np = 1 + (rem > l1 ? 1 : 0) + (rem > l1 + l2 ? 1 : 0); }
        return true;
    }
};
struct OrderOne {
    int pm, pn, nt;
    __device__ __forceinline__ bool next(int i, Unit& u) const { if (i != 0) return false; u.pm = pm; u.pn = pn; u.g = 0; u.k0 = 0; u.nkt = nt; u.role = 0; u.np = 0; return true; }
};
template <class Epi, class Sched, bool F8 = false>
__device__ __forceinline__ void gemm_phase(LAS unsigned char* lds, const Gemm g, const Sched& S, const Epi& E) {
    const int tid = opaque_tid(), wid = __builtin_amdgcn_readfirstlane(tid >> 6), lane = tid & 63, wr = wid >> 2, wc = wid & 3, fr = lane & 15, fq = lane >> 4;
    unsigned voffA[2], voffB[2];
#pragma unroll
    for (int i = 0; i < 2; ++i) { int R, C; stage_rc(tid * 16 + i * 8192, R, C); const int Rb = (R & ~31) + perm32(R & 31);
        voffA[i] = (unsigned)(R * g.lda + C) * 2u; voffB[i] = (unsigned)(Rb * g.ldb + C) * 2u; }
    const size_t kstep = (size_t)(BK * 2);
    const size_t hA = (size_t)HALF * g.lda * 2, hB = (size_t)HALF * g.ldb * 2;
    const unsigned ldsw = (unsigned)wid * 1024u;
    const int aoff = lds_byte(wr * 64 + fr, fq * 8), boff = lds_byte(wc * 32 + fr, fq * 8);
#define PG8_SA(b, h) (((b) * 2 + (h)) * HTB)
#define PG8_SB(b, h) ((4 + (b) * 2 + (h)) * HTB)
#define PG8_STAGE(bufoff, gbase, voff) do { _Pragma("unroll") for (int _i = 0; _i < 2; ++_i) \
        __builtin_amdgcn_global_load_lds((const unsigned*)((const char*)(gbase) + (voff)[_i]), (LAS unsigned*)(lds + (bufoff) + ldsw + _i * 8192), 16, 0, 0); } while (0)
#define PG8_LDA(dst, b, h) do { _Pragma("unroll") for (int m = 0; m < 4; ++m) { const i32x4 _l = *(const LAS i32x4*)(lds + PG8_SA(b, h) + aoff + m * 2048), _h = *(const LAS i32x4*)(lds + PG8_SA(b, h) + aoff + m * 2048 + 1024); dst[m] = __builtin_shufflevector(_l, _h, 0, 1, 2, 3, 4, 5, 6, 7); } } while (0)
#define PG8_LDB(dst, b, h) do { _Pragma("unroll") for (int n = 0; n < 2; ++n) { const i32x4 _l = *(const LAS i32x4*)(lds + PG8_SB(b, h) + boff + n * 2048), _h = *(const LAS i32x4*)(lds + PG8_SB(b, h) + boff + n * 2048 + 1024); dst[n] = __builtin_shufflevector(_l, _h, 0, 1, 2, 3, 4, 5, 6, 7); } } while (0)
#define PG8_MMA(ai, bj, At, Bt) do { __builtin_amdgcn_s_setprio(1); _Pragma("unroll") for (int m = 0; m < 4; ++m) _Pragma("unroll") for (int n = 0; n < 2; ++n) { \
        if constexpr (F8) asm volatile("s_nop 1\n\tv_mfma_scale_f32_16x16x128_f8f6f4 %0, %1, %2, %0, %3, %3 op_sel_hi:[0,0,0]" : "+v"(acc[ai][bj][m][n]) : "v"(Bt[n]), "v"(At[m]), "v"(f8sc)); \
        else { acc[ai][bj][m][n] = __builtin_amdgcn_mfma_f32_16x16x32_bf16(__builtin_bit_cast(bf16x8, __builtin_shufflevector(Bt[n], Bt[n], 0, 1, 2, 3)), __builtin_bit_cast(bf16x8, __builtin_shufflevector(At[m], At[m], 0, 1, 2, 3)), acc[ai][bj][m][n], 0, 0, 0); \
               acc[ai][bj][m][n] = __builtin_amdgcn_mfma_f32_16x16x32_bf16(__builtin_bit_cast(bf16x8, __builtin_shufflevector(Bt[n], Bt[n], 4, 5, 6, 7)), __builtin_bit_cast(bf16x8, __builtin_shufflevector(At[m], At[m], 4, 5, 6, 7)), acc[ai][bj][m][n], 0, 0, 0); } } \
        __builtin_amdgcn_s_setprio(0); } while (0)
#define PG8_WAIT_V(n) asm volatile("s_waitcnt vmcnt(" #n ")" ::: "memory")
#define PG8_WAIT_L(n) asm volatile("s_waitcnt lgkmcnt(" #n ")" ::: "memory")
#define PG8_BAR __builtin_amdgcn_s_barrier()
#define PG8_SCHED __builtin_amdgcn_sched_barrier(0)
    Unit cur, nxt; int ui = 0;
    if (!S.next(0, cur)) return;
    f32x4 acc[2][2][4][2];
#pragma unroll
    for (int a = 0; a < 2; ++a)
#pragma unroll
        for (int b = 0; b < 2; ++b)
#pragma unroll
            for (int m = 0; m < 4; ++m)
#pragma unroll
                for (int n = 0; n < 2; ++n) acc[a][b][m][n] = (f32x4){0.f, 0.f, 0.f, 0.f};
    i32x8 At[4], B0[2], B1[2];
    int f8sc = 0x7C7C7C7C;
    asm volatile("" : "+v"(f8sc));
    const char* cA = (const char*)(g.A + (size_t)cur.g * g.a_gs) + (size_t)cur.pm * 2 * hA + (size_t)cur.k0 * kstep;
    const char* cB = (const char*)(g.Bt + (size_t)cur.g * g.b_gs) + (size_t)cur.pn * 2 * hB + (size_t)cur.k0 * kstep;
    PG8_STAGE(PG8_SB(0, 0), cB, voffB); PG8_STAGE(PG8_SB(0, 1), cB + hB, voffB); PG8_STAGE(PG8_SA(0, 0), cA, voffA); PG8_STAGE(PG8_SA(0, 1), cA + hA, voffA);
    if (wr == 1) PG8_BAR;
    PG8_WAIT_V(2); PG8_BAR;
    PG8_STAGE(PG8_SB(1, 0), cB + kstep, voffB); PG8_STAGE(PG8_SA(1, 0), cA + kstep, voffA); PG8_STAGE(PG8_SB(1, 1), cB + hB + kstep, voffB);
    PG8_WAIT_V(6); PG8_BAR;
    for (;;) {
        const bool has_next = S.next(ui + 1, nxt);
        const char* nA = has_next ? (const char*)(g.A + (size_t)nxt.g * g.a_gs) + (size_t)nxt.pm * 2 * hA + (size_t)nxt.k0 * kstep : cA;
        const char* nB = has_next ? (const char*)(g.Bt + (size_t)nxt.g * g.b_gs) + (size_t)nxt.pn * 2 * hB + (size_t)nxt.k0 * kstep : cB;
        const int nt = cur.nkt;
        for (int t = 0; t < nt; t += 2) {
            const bool last = (t == nt - 2);
            const char* a1 = cA + (size_t)(t + 1) * kstep;
            const char* a2 = last ? nA : cA + (size_t)(t + 2) * kstep; const char* b2 = last ? nB : cB + (size_t)(t + 2) * kstep;
            const char* a3 = a2 + kstep; const char* b3 = b2 + kstep;
            PG8_LDB(B0, 0, 0); PG8_LDB(B1, 0, 1); PG8_SCHED; PG8_LDA(At, 0, 0); PG8_STAGE(PG8_SA(1, 1), a1 + hA, voffA);
            PG8_WAIT_V(8); PG8_WAIT_L(0); PG8_BAR; PG8_MMA(0, 0, At, B0); PG8_MMA(0, 1, At, B1); PG8_BAR; PG8_SCHED;
            PG8_LDA(At, 0, 1); PG8_STAGE(PG8_SB(0, 0), b2, voffB); PG8_STAGE(PG8_SB(0, 1), b2 + hB, voffB); PG8_STAGE(PG8_SA(0, 0), a2, voffA);
            PG8_WAIT_V(8); PG8_WAIT_L(0); PG8_BAR; PG8_MMA(1, 0, At, B0); PG8_MMA(1, 1, At, B1); PG8_BAR; PG8_SCHED;
            PG8_LDB(B0, 1, 0); PG8_LDB(B1, 1, 1); PG8_SCHED; PG8_LDA(At, 1, 0); PG8_STAGE(PG8_SA(0, 1), a2 + hA, voffA);
            PG8_WAIT_V(8); PG8_WAIT_L(0); PG8_BAR; PG8_MMA(0, 0, At, B0); PG8_MMA(0, 1, At, B1); PG8_BAR; PG8_SCHED;
            PG8_LDA(At, 1, 1); PG8_STAGE(PG8_SB(1, 0), b3, voffB); PG8_STAGE(PG8_SB(1, 1), b3 + hB, voffB); PG8_STAGE(PG8_SA(1, 0), a3, voffA);
            PG8_WAIT_V(8); PG8_WAIT_L(0); PG8_BAR; PG8_MMA(1, 0, At, B0); PG8_MMA(1, 1, At, B1); PG8_BAR; PG8_SCHED;
        }
        if (wr == 0) PG8_BAR;
        if constexpr (F8) asm volatile("s_nop 15\n\ts_nop 15" ::: "memory");
        E(acc, cur, wr, wc, fr, fq);
        if (!has_next) break;
#pragma unroll
        for (int a = 0; a < 2; ++a)
#pragma unroll
            for (int b = 0; b < 2; ++b)
#pragma unroll
                for (int m = 0; m < 4; ++m)
#pragma unroll
                    for (int n = 0; n < 2; ++n) acc[a][b][m][n] = (f32x4){0.f, 0.f, 0.f, 0.f};
        cur = nxt; cA = nA; cB = nB; ++ui;
        if (wr == 1) PG8_BAR;
    }
    PG8_WAIT_V(0);
    PG8_BAR;
#undef PG8_SA
#undef PG8_SB
#undef PG8_STAGE
#undef PG8_LDA
#undef PG8_LDB
#undef PG8_MMA
#undef PG8_WAIT_V
#undef PG8_WAIT_L
#undef PG8_BAR
#undef PG8_SCHED
}
}
using pg8::Unit;
typedef f32x4 AccT[2][2][4][2];

#define EPI_FOR_ROWS _Pragma("unroll") for (int ai = 0; ai < 2; ++ai) _Pragma("unroll") for (int m = 0; m < 4; ++m)
#define EPI_R (u.pm * 256 + ai * 128 + wr * 64 + m * 16 + fr)

struct EpiMod {
    float* mod; const float* b_ada;
    __device__ __forceinline__ void operator()(const AccT& acc, const Unit& u, int wr, int wc, int fr, int fq) const {
        EPI_FOR_ROWS { const int r = EPI_R;
            if (r < NBATCH) {
#pragma unroll
                for (int bj = 0; bj < 2; ++bj) {
                    const int c0 = u.pn * 256 + bj * 128 + wc * 32 + 8 * fq;
                    const f32x4 b0 = *(const f32x4*)(b_ada + c0), b1 = *(const f32x4*)(b_ada + c0 + 4);
                    *(f32x4*)(mod + (size_t)r * 12288 + c0) = acc[ai][bj][m][0] + b0; *(f32x4*)(mod + (size_t)r * 12288 + c0 + 4) = acc[ai][bj][m][1] + b1;
                }
            }
        }
    }
};
__device__ __forceinline__ void derive_pass(KP p, int wblk, int nblk) {
    const int gt = wblk * 512 + opaque_tid(), NGT = nblk * 512;
    const float* mod = (const float*)(p->ws + WS_MOD); bf16_t* sha = (bf16_t*)(p->ws + WS_SHA); float* gb = (float*)(p->ws + WS_GB);
    for (int i = gt; i < 2 * 2 * NBATCH * 256; i += NGT) {
        const int k = (i & 255) * 4, r = (i >> 8) % NBATCH, q = (i >> 8) / NBATCH, L = q >> 1, which = q & 1;
        const float* mr = mod + (size_t)r * 12288 + L * 6144 + which * 3072 + k;
        const f32x4 sh = *(const f32x4*)mr, sc = *(const f32x4*)(mr + 1024);
        const f32x4 gn = *(const f32x4*)(p->in[which ? 10 : 9] + L * 1024 + k);
        u32x2 w; w.x = pk2(sh[0], sh[1]); w.y = pk2(sh[2], sh[3]);
        *(u32x2*)(sha + ((size_t)q * 256 + r) * 1024 + k) = w;
        *(f32x4*)(gb + ((size_t)q * NBATCH + r) * 1024 + k) = gn * (sc + 1.f);
    }
}
struct EpiSW {
    float* o; int ld;
    __device__ __forceinline__ void operator()(const AccT& acc, const Unit& u, int wr, int wc, int fr, int fq) const {
        EPI_FOR_ROWS { const int r = EPI_R;
            if (r < NBATCH) {
#pragma unroll
                for (int bj = 0; bj < 2; ++bj) { float* p = o + (size_t)r * ld + u.pn * 256 + bj * 128 + wc * 32 + 8 * fq;
                    *(f32x4*)p = acc[ai][bj][m][0]; *(f32x4*)(p + 4) = acc[ai][bj][m][1]; }
            }}
    }
};
struct EpiG1 {
    bf16_t* Z; const float* rss; const float* sw; int h; float* vs; int pn0;
    __device__ __forceinline__ void operator()(const AccT& acc, const Unit& u, int wr, int wc, int fr, int fq) const {
        const int pn_ = u.pn + pn0;
        const bool gate = pn_ >= 24, vcol = (pn_ >> 2) == 2, fastb = u.pm < 32;
        const int colb = pn_ * 256 + wc * 32 + 8 * fq;
        f32x4 swv[2][2];
        if (fastb) { const float* swr = sw + (size_t)(4 * h + (u.pm >> 3)) * INC + colb;
#pragma unroll
            for (int bj = 0; bj < 2; ++bj) { swv[bj][0] = *(const f32x4*)(swr + bj * 128); swv[bj][1] = *(const f32x4*)(swr + bj * 128 + 4); } }
        EPI_FOR_ROWS { const int r = EPI_R;
            const f32x4 q = *(const f32x4*)(rss + (size_t)r * 16 + 4 * fq);
            float ssum = (q[0] + q[1]) + (q[2] + q[3]); ssum += __shfl_xor(ssum, 16); ssum += __shfl_xor(ssum, 32);
            const float rstd = __builtin_amdgcn_rsqf(ssum * (1.f / 1024.f) + EPS);
            if (!fastb) { const float* swr = sw + (size_t)batch_of(grow_of(r, h)) * INC + colb;
#pragma unroll
                for (int bj = 0; bj < 2; ++bj) { swv[bj][0] = *(const f32x4*)(swr + bj * 128); swv[bj][1] = *(const f32x4*)(swr + bj * 128 + 4); } }
            bf16_t* zr = Z + (size_t)r * INC + colb;
            float ls = 0.f, lq = 0.f;
#pragma unroll
            for (int bj = 0; bj < 2; ++bj) {
                f32x4 v0 = acc[ai][bj][m][0] * rstd + swv[bj][0], v1 = acc[ai][bj][m][1] * rstd + swv[bj][1];
                if (gate) {
#pragma unroll
                    for (int e = 0; e < 4; ++e) { v0[e] = sigm(v0[e]); v1[e] = sigm(v1[e]); } }
                u32x4 w; w.x = pk2(v0[0], v0[1]); w.y = pk2(v0[2], v0[3]); w.z = pk2(v1[0], v1[1]); w.w = pk2(v1[2], v1[3]);
                *(u32x4*)(zr + bj * 128) = w;
                if (vcol) {
#pragma unroll
                    for (int e = 0; e < 4; ++e) { ls += v0[e] + v1[e]; lq += v0[e] * v0[e] + v1[e] * v1[e]; }
                }
            }
            if (vcol) {
                ls += __shfl_xor(ls, 16); ls += __shfl_xor(ls, 32); lq += __shfl_xor(lq, 16); lq += __shfl_xor(lq, 32);
                if (fq == 0) *(f32x2*)(vs + (size_t)r * 32 + ((pn_ & 3) * 4 + wc) * 2) = (f32x2){ls, lq};
            }
        }
    }
};
struct EpiGate {
    bf16_t* Z; const float* rss; const float* sw; int h;
    __device__ __forceinline__ void operator()(const AccT& acc, const Unit& u, int wr, int wc, int fr, int fq) const {
        const int colb = (24 + u.pn) * 256 + wc * 32 + 8 * fq;
        EPI_FOR_ROWS { const int r = EPI_R;
            const f32x4 q = *(const f32x4*)(rss + (size_t)r * 16 + 4 * fq);
            float ssum = (q[0] + q[1]) + (q[2] + q[3]); ssum += __shfl_xor(ssum, 16); ssum += __shfl_xor(ssum, 32);
            const float rstd = __builtin_amdgcn_rsqf(ssum * (1.f / 1024.f) + EPS);
            const float* swr = sw + (size_t)batch_of(grow_of(r, h)) * INC + colb;
            bf16_t* zr = Z + (size_t)r * INC + colb;
#pragma unroll
            for (int bj = 0; bj < 2; ++bj) {
                const f32x4 s0 = *(const f32x4*)(swr + bj * 128), s1 = *(const f32x4*)(swr + bj * 128 + 4);
                f32x4 v0 = acc[ai][bj][m][0] * rstd + s0, v1 = acc[ai][bj][m][1] * rstd + s1;
#pragma unroll
                for (int e = 0; e < 4; ++e) { v0[e] = sigm(v0[e]); v1[e] = sigm(v1[e]); }
                u32x4 w; w.x = pk2(v0[0], v0[1]); w.y = pk2(v0[2], v0[3]); w.z = pk2(v1[0], v1[1]); w.w = pk2(v1[2], v1[3]);
                *(u32x4*)(zr + bj * 128) = w;
            }
        }
    }
};
struct EpiBR {
    bf16_t* Z;
    __device__ __forceinline__ void operator()(const AccT& acc, const Unit& u, int wr, int wc, int fr, int fq) const {
        EPI_FOR_ROWS { const int r = EPI_R;
            bf16_t* gp = Z + (size_t)r * INC + 6144 + u.g * 1024 + u.pn * 256 + wc * 32 + 8 * fq;
#pragma unroll
            for (int bj = 0; bj < 2; ++bj) {
                const u32x4 gw = *(const u32x4*)(gp + bj * 128);
                float gf[8]; unpack8(gw, gf);
                const f32x4 a0 = acc[ai][bj][m][0], a1 = acc[ai][bj][m][1];
                u32x4 w; w.x = pk2(a0[0] * gf[0], a0[1] * gf[1]); w.y = pk2(a0[2] * gf[2], a0[3] * gf[3]); w.z = pk2(a1[0] * gf[4], a1[1] * gf[5]); w.w = pk2(a1[2] * gf[6], a1[3] * gf[7]);
                *(u32x4*)(gp + bj * 128) = w;
            }}
    }
};
template <bool SK> struct EpiRes {
    const float* xp; const float* xs; float* out; const float* gatep; const float* Gn; bf16_t* XG; float* rss; int h, from_in, rss_global;
    unsigned char* XG8;
    float* slots; unsigned* flags; int cu;
    __device__ __forceinline__ void operator()(const AccT& acc, const Unit& u, int wr, int wc, int fr, int fq) const {
        if (SK && u.role == 1) {
            const unsigned* ubc = (const unsigned*)slots + (size_t)cu * 32768 + (wr * 4 + wc) * 4096;
            const int li = (fq * 16 + fr) * 4;
#pragma unroll
            for (int ai = 0; ai < 2; ++ai)
#pragma unroll
                for (int bj = 0; bj < 2; ++bj)
#pragma unroll
                    for (int m = 0; m < 4; ++m) {
                        unsigned* ub = (unsigned*)ubc + ((ai * 2 + bj) * 4 + m) * 256;
                        asm volatile("" : "+s"(ub));
                        const f32x4 d0 = acc[ai][bj][m][0], d1 = acc[ai][bj][m][1];
                        u32x4 w; w.x = pk2(d0[0], d0[1]); w.y = pk2(d0[2], d0[3]); w.z = pk2(d1[0], d1[1]); w.w = pk2(d1[2], d1[3]);
                        *(u32x4*)(ub + li) = w;
                    }
            asm volatile("s_waitcnt vmcnt(0)" ::: "memory");
            __builtin_amdgcn_s_barrier();
            if (wr == 0 && wc == 0) {
                __builtin_amdgcn_fence(__ATOMIC_RELEASE, "agent");
                asm volatile("s_waitcnt vmcnt(0)" ::: "memory");
                if ((fq * 16 + fr) == 0) (void)xb_add(flags + cu, 8u);
            }
            return;
        }
        if (SK && u.role == 2) {
            if (wr == 0 && wc == 0) {
                for (int q = 1; q <= u.np; ++q) {
                    unsigned sp = 0;
                    while (xb_ld(flags + cu + q) < 8u) { __builtin_amdgcn_s_sleep(2); if (++sp > (1u << 22)) break; }
                }
                __builtin_amdgcn_fence(__ATOMIC_ACQUIRE, "agent");
                asm volatile("s_waitcnt vmcnt(0)" ::: "memory");
            }
            __builtin_amdgcn_s_barrier();
        }
        const bool fastb = u.pm < 32;
        const int cb = u.pn * 256 + wc * 32 + 8 * fq;
        f32x4 gv[2][2], qv[2][2];
        if (fastb) { const int b = 4 * h + (u.pm >> 3);
#pragma unroll
            for (int bj = 0; bj < 2; ++bj) { const float* gr = gatep + (size_t)b * 12288 + cb + bj * 128; gv[bj][0] = *(const f32x4*)gr; gv[bj][1] = *(const f32x4*)(gr + 4);
                if (Gn) { const float* gg = Gn + (size_t)b * 1024 + cb + bj * 128; qv[bj][0] = *(const f32x4*)gg; qv[bj][1] = *(const f32x4*)(gg + 4); } } }
        EPI_FOR_ROWS { const int r = EPI_R;
            const int grow = grow_of(r, h);
            if (!fastb) { const int b = batch_of(grow);
#pragma unroll
                for (int bj = 0; bj < 2; ++bj) { const float* gr = gatep + (size_t)b * 12288 + cb + bj * 128; gv[bj][0] = *(const f32x4*)gr; gv[bj][1] = *(const f32x4*)(gr + 4);
                    if (Gn) { const float* gg = Gn + (size_t)b * 1024 + cb + bj * 128; qv[bj][0] = *(const f32x4*)gg; qv[bj][1] = *(const f32x4*)(gg + 4); } } }
            const float* xr = (!SK && from_in) ? (grow < 16384 ? xp + (size_t)grow * 1024 : xs + (size_t)(grow - 16384) * 1024) : out + (size_t)grow * 1024;
            float* orow = out + (size_t)grow * 1024;
            float ss = 0.f;
#pragma unroll
            for (int bj = 0; bj < 2; ++bj) {
                const int c0 = cb + bj * 128;
                const f32x4 x0 = *(const f32x4*)(xr + c0), x1 = *(const f32x4*)(xr + c0 + 4);
                f32x4 a0 = acc[ai][bj][m][0], a1 = acc[ai][bj][m][1];
                if (SK && u.role == 2) {
                    const unsigned* ub = (const unsigned*)slots + (size_t)(cu + 1) * 32768 + (wr * 4 + wc) * 4096 + ((ai * 2 + bj) * 4 + m) * 256;
                    asm volatile("" : "+s"(ub));
                    const int li = (fq * 16 + fr) * 4;
                    { const u32x4 w = *(const u32x4*)(ub + li); a0 += (f32x4){lo_f(w.x), hi_f(w.x), lo_f(w.y), hi_f(w.y)}; a1 += (f32x4){lo_f(w.z), hi_f(w.z), lo_f(w.w), hi_f(w.w)}; }
                    if (u.np >= 2) { const u32x4 w = *(const u32x4*)(ub + 32768 + li); a0 += (f32x4){lo_f(w.x), hi_f(w.x), lo_f(w.y), hi_f(w.y)}; a1 += (f32x4){lo_f(w.z), hi_f(w.z), lo_f(w.w), hi_f(w.w)}; }
                    if (u.np >= 3) { const u32x4 w = *(const u32x4*)(ub + 65536 + li); a0 += (f32x4){lo_f(w.x), hi_f(w.x), lo_f(w.y), hi_f(w.y)}; a1 += (f32x4){lo_f(w.z), hi_f(w.z), lo_f(w.w), hi_f(w.w)}; }
                }
                const f32x4 v0 = x0 + gv[bj][0] * a0, v1 = x1 + gv[bj][1] * a1;
                *(f32x4*)(orow + c0) = v0; *(f32x4*)(orow + c0 + 4) = v1;
                ss += (v0[0] * v0[0] + v0[1] * v0[1]) + (v0[2] * v0[2] + v0[3] * v0[3]) + (v1[0] * v1[0] + v1[1] * v1[1]) + (v1[2] * v1[2] + v1[3] * v1[3]);
                if (Gn) {
                    const f32x4 q0 = qv[bj][0], q1 = qv[bj][1];
                    u32x4 w; w.x = pk2(v0[0] * q0[0], v0[1] * q0[1]); w.y = pk2(v0[2] * q0[2], v0[3] * q0[3]); w.z = pk2(v1[0] * q1[0], v1[1] * q1[1]); w.w = pk2(v1[2] * q1[2], v1[3] * q1[3]);
                    *(u32x4*)(XG + (size_t)r * 1024 + c0) = w;
                    if (XG8) { u32x2 w8; w8.x = pk4_fp8(v0[0] * q0[0], v0[1] * q0[1], v0[2] * q0[2], v0[3] * q0[3]); w8.y = pk4_fp8(v1[0] * q1[0], v1[1] * q1[1], v1[2] * q1[2], v1[3] * q1[3]); *(u32x2*)(XG8 + (size_t)r * 1024 + c0) = w8; }
                }
            }
            ss += __shfl_xor(ss, 16); ss += __shfl_xor(ss, 32);
            if (fq == 0) rss[(size_t)(rss_global ? grow : r) * 16 + u.pn * 4 + wc] = ss;
        }
    }
};
struct EpiFF1 {
    bf16_t* H; const float* rss; const float* sw; int h; unsigned* done;
    __device__ __forceinline__ void operator()(const AccT& acc, const Unit& u, int wr, int wc, int fr, int fq) const {
        const bool fastb = u.pm < 32;
        const int colb = u.pn * 256 + wc * 32 + 8 * fq;
        f32x4 swv[2][2];
        if (fastb) { const float* swr = sw + (size_t)(4 * h + (u.pm >> 3)) * DFF + colb;
#pragma unroll
            for (int bj = 0; bj < 2; ++bj) { swv[bj][0] = *(const f32x4*)(swr + bj * 128); swv[bj][1] = *(const f32x4*)(swr + bj * 128 + 4); } }
        EPI_FOR_ROWS { const int r = EPI_R;
            const f32x4 q = *(const f32x4*)(rss + (size_t)r * 16 + 4 * fq);
            float ssum = (q[0] + q[1]) + (q[2] + q[3]); ssum += __shfl_xor(ssum, 16); ssum += __shfl_xor(ssum, 32);
            const float rstd = __builtin_amdgcn_rsqf(ssum * (1.f / 1024.f) + EPS);
            if (!fastb) { const float* swr = sw + (size_t)batch_of(grow_of(r, h)) * DFF + colb;
#pragma unroll
                for (int bj = 0; bj < 2; ++bj) { swv[bj][0] = *(const f32x4*)(swr + bj * 128); swv[bj][1] = *(const f32x4*)(swr + bj * 128 + 4); } }
            bf16_t* hr = H + (size_t)r * DFF + colb;
#pragma unroll
            for (int bj = 0; bj < 2; ++bj) {
                f32x4 v0 = acc[ai][bj][m][0] * rstd + swv[bj][0], v1 = acc[ai][bj][m][1] * rstd + swv[bj][1];
#pragma unroll
                for (int e = 0; e < 4; ++e) { const float a = fmaxf(v0[e], 0.f), c = fmaxf(v1[e], 0.f); v0[e] = a * a; v1[e] = c * c; }
                u32x4 w; w.x = pk2(v0[0], v0[1]); w.y = pk2(v0[2], v0[3]); w.z = pk2(v1[0], v1[1]); w.w = pk2(v1[2], v1[3]);
                *(u32x4*)(hr + bj * 128) = w;
            }
        }
        if (done) {
            asm volatile("s_waitcnt vmcnt(0)" ::: "memory");
            __builtin_amdgcn_s_barrier();
            if (wr == 0 && wc == 0) {
                __builtin_amdgcn_fence(__ATOMIC_RELEASE, "agent");
                asm volatile("s_waitcnt vmcnt(0)" ::: "memory");
                if ((fq * 16 + fr) == 0) (void)xb_add(done, 1u);
            }
        }
    }
};

#define TR_LOAD(tv, W_, ldw_, k0_, n0_) do { _Pragma("unroll") for (int _i = 0; _i < 8; ++_i) tv[_i] = *(const f32x4*)((W_) + (size_t)((k0_) + 8 * _i + (lane >> 3)) * (ldw_) + (n0_) + (lane & 7) * 4); } while (0)
__device__ __forceinline__ void tr_store(const f32x4 (&tv)[8], bf16_t* WT, int ldt, int k0, int n0, float* scr, int lane, int ncopy, int copy_stride) {
#pragma unroll
    for (int i = 0; i < 8; ++i) { float* d = scr + (8 * i + (lane >> 3)) * 33 + (lane & 7) * 4; d[0] = tv[i][0]; d[1] = tv[i][1]; d[2] = tv[i][2]; d[3] = tv[i][3]; }
    LDS_WAIT();
    const int c = lane & 7;
#pragma unroll
    for (int j = 0; j < 4; ++j) { const int n = (lane >> 3) + 8 * j; const float* s = scr + (8 * c) * 33 + n;
        u32x4 o; o.x = pk2(s[0], s[33]); o.y = pk2(s[66], s[99]); o.z = pk2(s[132], s[165]); o.w = pk2(s[198], s[231]);
        for (int cp = 0; cp < ncopy; ++cp) *(u32x4*)(WT + (size_t)(n0 + n) * ldt + (size_t)cp * copy_stride + k0 + 8 * c) = o; }
    LDS_WAIT();
}
__device__ __forceinline__ void tr_item(const float* W, int ldw, bf16_t* WT, int ldt, int k0, int n0, float* scr, int lane, int ncopy, int copy_stride) {
    f32x4 tv[8];
    TR_LOAD(tv, W, ldw, k0, n0);
    tr_store(tv, WT, ldt, k0, n0, scr, lane, ncopy, copy_stride);
}
__device__ __forceinline__ void tr_job(const float* W, int K, int N, bf16_t* WT, int ldt, int ncopy, int copy_stride, int gw, int NGW, float* scr, int lane, int ldw = 0) {
    if (ldw == 0) ldw = N;
    const int nblk = N / 32, items = (K / 64) * nblk;
    f32x4 ta[8], tb[8];
    int it = gw; bool ha = it < items;
    if (ha) TR_LOAD(ta, W, ldw, (it / nblk) * 64, (it % nblk) * 32);
    for (;;) {
        const int itb = it + NGW; const bool hb = itb < items;
        if (hb) TR_LOAD(tb, W, ldw, (itb / nblk) * 64, (itb % nblk) * 32);
        if (!ha) break;
        tr_store(ta, WT, ldt, (it / nblk) * 64, (it % nblk) * 32, scr, lane, ncopy, copy_stride);
        it = itb + NGW; ha = it < items;
        if (ha) TR_LOAD(ta, W, ldw, (it / nblk) * 64, (it % nblk) * 32);
        if (!hb) break;
        tr_store(tb, WT, ldt, (itb / nblk) * 64, (itb % nblk) * 32, scr, lane, ncopy, copy_stride);
    }
}
__device__ __forceinline__ void p0_convert(KP p, unsigned char* smem, int part, int wblk, int nblk) {
    const int tid = opaque_tid(), lane = tid & 63, wave = tid >> 6;
    const int gw = wblk * 8 + wave, NGW = nblk * 8;
    float* scr = (float*)(smem + wave * 8448);
    unsigned char* ws = p->ws;
    const int gt = wblk * 512 + tid, NGT = nblk * 512;
    if (part == 0) {
        for (int l = 0; l < 2; ++l) tr_job(p->in[7] + (size_t)l * 1024 * 6144, 1024, 6144, (bf16_t*)(ws + WS_Z) + (size_t)l * 6144 * 1024, 1024, 1, 0, (gw + 832 * l) % NGW, NGW, scr, lane);
        for (int i = gt; i < 256 * 1024 / 8; i += NGT) {
            const int row = i >> 7, k = (i & 127) * 8;
            u32x4 o = {0u, 0u, 0u, 0u};
            if (row < NBATCH) {
                const float* c = row < 8 ? p->in[2] + (size_t)row * 1024 + k : p->in[3] + (size_t)(row - 8) * 1024 + k;
                float f[8];
#pragma unroll
                for (int e = 0; e < 8; ++e) { const float v = c[e]; f[e] = v * sigm(v); }
                o = pack8(f);
            }
            *(u32x4*)((bf16_t*)(ws + WS_CA) + (size_t)row * 1024 + k) = o;
        }
        return;
    }
    for (int l = 0; l < 2; ++l) {
        tr_job(p->in[12] + (size_t)l * 1024 * INC, 1024, 6144, (bf16_t*)(ws + WS_WIN) + (size_t)l * 6144 * 1024, 1024, 1, 0, gw, NGW, scr, lane, INC);
        {
            const float* Wg = p->in[12] + (size_t)l * 1024 * INC + 6144;
            bf16_t* Tb = (bf16_t*)(ws + WS_Z + ZT_GATE) + (size_t)l * 3072 * 1024; unsigned char* T8 = ws + WS_W8 + (size_t)l * 3072 * 1024;
            for (int it = (gw + 700) % NGW; it < 16 * 96; it += NGW) {
                const int k0 = (it / 96) * 64, n0 = (it % 96) * 32;
                f32x4 tv[8];
                TR_LOAD(tv, Wg, INC, k0, n0);
#pragma unroll
                for (int i = 0; i < 8; ++i) { float* d = scr + (8 * i + (lane >> 3)) * 33 + (lane & 7) * 4; d[0] = tv[i][0]; d[1] = tv[i][1]; d[2] = tv[i][2]; d[3] = tv[i][3]; }
                LDS_WAIT();
                { const int c = lane & 7;
#pragma unroll
                  for (int j = 0; j < 4; ++j) { const int n = (lane >> 3) + 8 * j; const float* q = scr + (8 * c) * 33 + n;
                      u32x4 o; o.x = pk2(q[0], q[33]); o.y = pk2(q[66], q[99]); o.z = pk2(q[132], q[165]); o.w = pk2(q[198], q[231]);
                      *(u32x4*)(Tb + (size_t)(n0 + n) * 1024 + k0 + 8 * c) = o; } }
                { const int c = lane & 3;
#pragma unroll
                  for (int j = 0; j < 2; ++j) { const int n = (lane >> 2) + 16 * j; const float* q = scr + (16 * c) * 33 + n;
                      u32x4 o;
                      o.x = pk4_fp8(64.f * q[0], 64.f * q[33], 64.f * q[66], 64.f * q[99]); o.y = pk4_fp8(64.f * q[132], 64.f * q[165], 64.f * q[198], 64.f * q[231]);
                      o.z = pk4_fp8(64.f * q[264], 64.f * q[297], 64.f * q[330], 64.f * q[363]); o.w = pk4_fp8(64.f * q[396], 64.f * q[429], 64.f * q[462], 64.f * q[495]);
                      *(u32x4*)(T8 + (size_t)(n0 + n) * 1024 + k0 + 16 * c) = o; } }
                LDS_WAIT();
            }
        }
        tr_job(p->in[29] + (size_t)l * 1024 * DFF, 1024, DFF, (bf16_t*)(ws + WS_WF1) + (size_t)l * DFF * 1024, 1024, 1, 0, (gw + 1024) % NGW, NGW, scr, lane);
        tr_job(p->in[30] + (size_t)l * DFF * 1024, DFF, 1024, (bf16_t*)(ws + WS_WF2) + (size_t)l * 1024 * DFF, DFF, 1, 0, gw, NGW, scr, lane);
        for (int br = 0; br < 3; ++br)
            tr_job(p->in[25 + br] + (size_t)l * 1024 * 1024, 1024, 1024, (bf16_t*)(ws + WS_WBR) + ((size_t)l * 3 + br) * 1024 * 1024, 1024, 1, 0, (gw + 512 * br) % NGW, NGW, scr, lane);
        tr_job(p->in[28] + (size_t)l * 1024 * 1024, 1024, 1024, (bf16_t*)(ws + WS_WO3) + (size_t)l * 1024 * 1024, 1024, 1, 0, (gw + 1536) % NGW, NGW, scr, lane);
    }
    for (int job = gw; job < 128; job += NGW) {
        const int nb = job & 1, mat = (job >> 1) & 1, lh = job >> 2;
        const float* W = p->in[mat ? 17 : 15] + (size_t)lh * 4096;
        tr_item(W, 64, (bf16_t*)(ws + WS_LRUW) + (size_t)lh * 8192 + mat * 4096, 64, 0, nb * 32, scr, lane, 1, 0);
    }
    for (int i = gt; i < 2 * 16 * 128 * 128 / 8; i += NGT) {
        const f32x4 a = *(const f32x4*)(p->in[22] + (size_t)i * 8), b = *(const f32x4*)(p->in[22] + (size_t)i * 8 + 4);
        u32x4 o; o.x = pk2(a[0], a[1]); o.y = pk2(a[2], a[3]); o.z = pk2(b[0], b[1]); o.w = pk2(b[2], b[3]);
        *(u32x4*)((bf16_t*)(ws + WS_CMW) + (size_t)i * 8) = o;
    }
}
__device__ __forceinline__ void xg0_pass(KP p, int h, int wblk, int nblk) {
    const int tid_ = opaque_tid(), lane = tid_ & 63, gw = wblk * 8 + (tid_ >> 6), NGW = nblk * 8;
    const float* G1 = (const float*)(p->ws + WS_GB);
    bf16_t* XG = (bf16_t*)(p->ws + WS_XG); float* rsa = (float*)(p->ws + WS_RSA);
    for (int r = gw; r < MH; r += NGW) {
        const int grow = grow_of(r, h), b = batch_of(grow);
        const float* xr = grow < 16384 ? p->in[0] + (size_t)grow * 1024 : p->in[1] + (size_t)(grow - 16384) * 1024;
        const float* g = G1 + (size_t)b * 1024;
        float ss = 0.f;
#pragma unroll
        for (int j = 0; j < 4; ++j) {
            const int c = lane * 4 + 256 * j;
            const f32x4 v = *(const f32x4*)(xr + c), q = *(const f32x4*)(g + c);
            ss += (v[0] * v[0] + v[1] * v[1]) + (v[2] * v[2] + v[3] * v[3]);
            u32x2 w; w.x = pk2(v[0] * q[0], v[1] * q[1]); w.y = pk2(v[2] * q[2], v[3] * q[3]);
            *(u32x2*)(XG + (size_t)r * 1024 + c) = w;
            *(unsigned*)(p->ws + WS_XG8 + (size_t)r * 1024 + c) = pk4_fp8(v[0] * q[0], v[1] * q[1], v[2] * q[2], v[3] * q[3]);
        }
        ss = wave_sum(ss);
        if (lane < 16) rsa[(size_t)r * 16 + lane] = lane == 0 ? ss : 0.f;
    }
}
__device__ __forceinline__ void final_pass(KP p, int h, int wblk, int nblk) {
    const int tid_ = opaque_tid(), lane = tid_ & 63, gw = wblk * 8 + (tid_ >> 6), NGW = nblk * 8;
    const float* rsf = (const float*)(p->ws + WS_RSF); const float* gf = p->in[11];
    f32x4 q[4];
#pragma unroll
    for (int j = 0; j < 4; ++j) q[j] = *(const f32x4*)(gf + lane * 4 + 256 * j);
    for (int r0 = gw; r0 < MH; r0 += 2 * NGW) {
        f32x4 v[2][4]; float rs[2];
#pragma unroll
        for (int r = 0; r < 2; ++r) { const int lr = r0 + r * NGW; if (lr < MH) { const int grow = grow_of(lr, h); rs[r] = sum16(rsf + (size_t)grow * 16);
#pragma unroll
            for (int j = 0; j < 4; ++j) v[r][j] = *(const f32x4*)(p->out + (size_t)grow * 1024 + lane * 4 + 256 * j); } }
#pragma unroll
        for (int r = 0; r < 2; ++r) { const int lr = r0 + r * NGW; if (lr < MH) { const int grow = grow_of(lr, h); const float rstd = __builtin_amdgcn_rsqf(rs[r] * (1.f / 1024.f) + EPS);
#pragma unroll
            for (int j = 0; j < 4; ++j) *(f32x4*)(p->out + (size_t)grow * 1024 + lane * 4 + 256 * j) = v[r][j] * rstd * q[j]; } }
    }
}
__device__ __forceinline__ void sum_pass(KP p) {
    bf16_t* Z = (bf16_t*)(p->ws + WS_Z);
    const int gt = blockIdx.x * 512 + opaque_tid(), NGT = gridDim.x * 512;
    for (int i0 = gt; i0 < MH * 128; i0 += 4 * NGT) {
        u32x4 a[4], b[4], c[4];
#pragma unroll
        for (int j = 0; j < 4; ++j) { const int i = i0 + j * NGT; if (i < MH * 128) { const bf16_t* z = Z + (size_t)(i >> 7) * INC + 6144 + (i & 127) * 8; a[j] = *(const u32x4*)z; b[j] = *(const u32x4*)(z + 1024); c[j] = *(const u32x4*)(z + 2048); } }
#pragma unroll
        for (int j = 0; j < 4; ++j) { const int i = i0 + j * NGT; if (i < MH * 128) {
            float fa[8], fb[8], fc[8]; unpack8(a[j], fa); unpack8(b[j], fb); unpack8(c[j], fc);
#pragma unroll
            for (int e = 0; e < 8; ++e) fa[e] = (fa[e] + fb[e]) + fc[e];
            *(u32x4*)(Z + (size_t)(i >> 7) * INC + 6144 + (i & 127) * 8) = pack8(fa); } }
    }
}
__device__ __forceinline__ void ln_from_partials(const float* vs, float& mean, float& rstd) {
    float s = 0.f, q = 0.f;
#pragma unroll
    for (int i = 0; i < 8; ++i) { const f32x4 v = *(const f32x4*)(vs + 4 * i); s += v[0] + v[2]; q += v[1] + v[3]; }
    mean = s * (1.f / 1024.f);
    const float var = fmaxf(q * (1.f / 1024.f) - mean * mean, 0.f);
    rstd = __builtin_amdgcn_rsqf(var + EPS);
}
__device__ __forceinline__ void mixC_item(KP p, int l, int h, int item) {
    bf16_t* Z = (bf16_t*)(p->ws + WS_Z);
    const int tid = opaque_tid(), ch0 = (tid & 127) * 8, sub = tid >> 7, r0 = item * 32 + sub * 8;
    const bool prompt = r0 < 8192;
    const bool halo = prompt && (r0 & 2047) != 0;
    u32x4 gbw[8], gcw[8], xcw[8], hg[2], hx[2];
#pragma unroll
    for (int i = 0; i < 8; ++i) { const bf16_t* zr = Z + (size_t)(r0 + i) * INC + ch0; gbw[i] = *(const u32x4*)(zr + 3072); gcw[i] = *(const u32x4*)(zr + 4096); xcw[i] = *(const u32x4*)(zr + 5120); }
    float q1[8], q2[8];
    int js = 0;
    if (halo) {
#pragma unroll
        for (int i = 0; i < 2; ++i) { const bf16_t* zr = Z + (size_t)(r0 - 1 - i) * INC + ch0; hg[i] = *(const u32x4*)(zr + 4096); hx[i] = *(const u32x4*)(zr + 5120); }
        float a[8], b[8];
        unpack8(hg[0], a); unpack8(hx[0], b);
#pragma unroll
        for (int e = 0; e < 8; ++e) q1[e] = a[e] * b[e];
        unpack8(hg[1], a); unpack8(hx[1], b);
#pragma unroll
        for (int e = 0; e < 8; ++e) q2[e] = a[e] * b[e];
    } else if (!prompt) {
        js = 64 * h + ((r0 - 8192) >> 3);
        const float* st = p->in[6] + ((size_t)(l * 128 + js) * 2) * 1024 + ch0;
        const f32x4 a0 = *(const f32x4*)st, a1 = *(const f32x4*)(st + 4), b0 = *(const f32x4*)(st + 1024), b1 = *(const f32x4*)(st + 1028);
#pragma unroll
        for (int e = 0; e < 4; ++e) { q2[e] = a0[e]; q2[4 + e] = a1[e]; q1[e] = b0[e]; q1[4 + e] = b1[e]; }
    } else {
#pragma unroll
        for (int e = 0; e < 8; ++e) { q1[e] = 0.f; q2[e] = 0.f; }
    }
    const float* w = p->in[24] + (size_t)l * 3 * 1024 + ch0;
    float w0[8], w1[8], w2[8];
    { const f32x4 a = *(const f32x4*)w, b = *(const f32x4*)(w + 4), c = *(const f32x4*)(w + 1024), d = *(const f32x4*)(w + 1028), e2 = *(const f32x4*)(w + 2048), f = *(const f32x4*)(w + 2052);
#pragma unroll
      for (int e = 0; e < 4; ++e) { w0[e] = a[e]; w0[4 + e] = b[e]; w1[e] = c[e]; w1[4 + e] = d[e]; w2[e] = e2[e]; w2[4 + e] = f[e]; } }
#pragma unroll
    for (int i = 0; i < 8; ++i) {
        float gbv[8], gcv[8], xcv[8], y[8];
        unpack8(gbw[i], gbv); unpack8(gcw[i], gcv); unpack8(xcw[i], xcv);
#pragma unroll
        for (int e = 0; e < 8; ++e) { const float q = gcv[e] * xcv[e]; y[e] = gbv[e] * (w0[e] * q2[e] + w1[e] * q1[e] + w2[e] * q); q2[e] = q1[e]; q1[e] = q; }
        *(u32x4*)(Z + (size_t)(r0 + i) * INC + 2048 + ch0) = pack8(y);
    }
    float* o = nullptr;
    if (prompt) { if (((r0 + 7) & 2047) == 2047) o = p->out + O_SCP + ((size_t)(l * 8 + 4 * h + (r0 >> 11)) * 2) * 1024 + ch0; }
    else o = p->out + O_SCS + ((size_t)(l * 128 + js) * 2) * 1024 + ch0;
    if (o) {
        *(f32x4*)o = (f32x4){q2[0], q2[1], q2[2], q2[3]}; *(f32x4*)(o + 4) = (f32x4){q2[4], q2[5], q2[6], q2[7]};
        *(f32x4*)(o + 1024) = (f32x4){q1[0], q1[1], q1[2], q1[3]}; *(f32x4*)(o + 1028) = (f32x4){q1[4], q1[5], q1[6], q1[7]};
    }
}
__device__ __forceinline__ void mixB_prompt_item(KP p, int l, int item, unsigned char* smem) {
    bf16_t* Z = (bf16_t*)(p->ws + WS_Z);
    const int tid = opaque_tid(), lane = tid & 63, wid = tid >> 6, fr = lane & 15, fq = lane >> 4;
    const int chunk = item >> 2, cb = item & 3;
    const int r0 = (chunk >> 4) * 2048 + (chunk & 15) * 128;
    float* st = (float*)smem; unsigned* vnT = (unsigned*)(smem + 1024);
    const float* lng = p->in[20] + (size_t)l * 1024 + cb * 256; const float* lnb = p->in[21] + (size_t)l * 1024 + cb * 256;
    const bf16_t* CW = (const bf16_t*)(p->ws + WS_CMW) + (size_t)l * 16 * 128 * 128;
    const float* bs = p->in[23] + (size_t)l * 16 * 128;
    u32x4 va[4], vb[4];
#pragma unroll
    for (int i = 0; i < 4; ++i) { const bf16_t* vr = Z + (size_t)(r0 + 2 * lane) * INC + 2048 + cb * 256 + (wid * 4 + i) * 8; va[i] = *(const u32x4*)vr; vb[i] = *(const u32x4*)(vr + INC); }
    if (tid < 128) { float mean, rstd; ln_from_partials((const float*)(p->ws + WS_VS) + (size_t)(r0 + tid) * 32, mean, rstd); st[tid * 2] = mean; st[tid * 2 + 1] = rstd; }
    __syncthreads();
    {
        const f32x4 sm = *(const f32x4*)(st + 4 * lane);
#pragma unroll
        for (int i = 0; i < 4; ++i) {
            const int chl0 = (wid * 4 + i) * 8;
            const f32x4 g0 = *(const f32x4*)(lng + chl0), g1 = *(const f32x4*)(lng + chl0 + 4), b0 = *(const f32x4*)(lnb + chl0), b1 = *(const f32x4*)(lnb + chl0 + 4);
            float fa[8], fb[8]; unpack8(va[i], fa); unpack8(vb[i], fb);
#pragma unroll
            for (int e = 0; e < 8; ++e) {
                const float gg = e < 4 ? g0[e & 3] : g1[e & 3], bb = e < 4 ? b0[e & 3] : b1[e & 3];
                vnT[(chl0 + e) * 68 + lane] = pk2((fa[e] - sm[0]) * sm[1] * gg + bb, (fb[e] - sm[2]) * sm[3] * gg + bb);
            }
        }
    }
    __syncthreads();
    const int gl = wid >> 1, th = wid & 1, gg = cb * 4 + gl;
    bf16x8 Bf[4][4];
    u32x2 uw[4][4];
#pragma unroll
    for (int ks = 0; ks < 4; ++ks)
#pragma unroll
        for (int ni = 0; ni < 4; ++ni) {
            if (ks * 32 <= 64 * th + 16 * ni + 15) Bf[ks][ni] = *(const bf16x8*)(CW + ((size_t)gg * 128 + 64 * th + 16 * ni + fr) * 128 + ks * 32 + fq * 8);
        }
#pragma unroll
    for (int ni = 0; ni < 4; ++ni)
#pragma unroll
        for (int mi = 0; mi < 4; ++mi) uw[mi][ni] = *(const u32x2*)(Z + (size_t)(r0 + 64 * th + 16 * ni + fr) * INC + 1024 + cb * 256 + gl * 64 + mi * 16 + 4 * fq);
    f32x4 acc[4][4];
#pragma unroll
    for (int a = 0; a < 4; ++a)
#pragma unroll
        for (int b = 0; b < 4; ++b) acc[a][b] = (f32x4){0.f, 0.f, 0.f, 0.f};
#pragma unroll
    for (int ks = 0; ks < 4; ++ks) {
        if (ks * 32 <= 64 * th + 63) {
            bf16x8 A[4];
#pragma unroll
            for (int mi = 0; mi < 4; ++mi) A[mi] = *(const bf16x8*)((const bf16_t*)vnT + (gl * 64 + mi * 16 + fr) * 136 + ks * 32 + fq * 8);
#pragma unroll
            for (int ni = 0; ni < 4; ++ni) {
                if (ks * 32 <= 64 * th + 16 * ni + 15) {
                    const int t = 64 * th + 16 * ni + fr, s0 = ks * 32 + fq * 8;
                    bf16x8 B = Bf[ks][ni];
#pragma unroll
                    for (int e = 0; e < 8; ++e) if (s0 + e > t) B[e] = 0;
#pragma unroll
                    for (int mi = 0; mi < 4; ++mi) acc[mi][ni] = __builtin_amdgcn_mfma_f32_16x16x32_bf16(A[mi], B, acc[mi][ni], 0, 0, 0);
                }
            }
        }
    }
#pragma unroll
    for (int ni = 0; ni < 4; ++ni) {
        const int t = 64 * th + 16 * ni + fr;
        const float bsv = bs[gg * 128 + t];
#pragma unroll
        for (int mi = 0; mi < 4; ++mi) {
            const u32x2 w = uw[mi][ni];
            u32x2 o; o.x = pk2(lo_f(w.x) * (acc[mi][ni][0] + bsv), hi_f(w.x) * (acc[mi][ni][1] + bsv)); o.y = pk2(lo_f(w.y) * (acc[mi][ni][2] + bsv), hi_f(w.y) * (acc[mi][ni][3] + bsv));
            *(u32x2*)(Z + (size_t)(r0 + t) * INC + 1024 + cb * 256 + gl * 64 + mi * 16 + 4 * fq) = o;
        }
    }
    __syncthreads();
}
__device__ __forceinline__ void mixB_sample_item(KP p, int l, int h, int item) {
    bf16_t* Z = (bf16_t*)(p->ws + WS_Z);
    const int tid = opaque_tid(), lane = tid & 63, wid = tid >> 6;
    const int unit = item * 8 + wid, j = unit >> 1, hf = unit & 1, js = 64 * h + j, rb = 8192 + j * 8;
    const int ch0 = hf * 512 + lane * 8, g = ch0 >> 6;
    u32x4 vw[8], uw[8];
#pragma unroll
    for (int t = 0; t < 8; ++t) { const bf16_t* zr = Z + (size_t)(rb + t) * INC + ch0; vw[t] = *(const u32x4*)(zr + 2048); uw[t] = *(const u32x4*)(zr + 1024); }
    float mean, rstd;
    ln_from_partials((const float*)(p->ws + WS_VS) + (size_t)(rb + (lane & 7)) * 32, mean, rstd);
    const float* lng = p->in[20] + (size_t)l * 1024 + ch0; const float* lnb = p->in[21] + (size_t)l * 1024 + ch0;
    float gv[8], bv[8];
    { const f32x4 a = *(const f32x4*)lng, b = *(const f32x4*)(lng + 4), c = *(const f32x4*)lnb, d = *(const f32x4*)(lnb + 4);
#pragma unroll
      for (int e = 0; e < 4; ++e) { gv[e] = a[e]; gv[4 + e] = b[e]; bv[e] = c[e]; bv[4 + e] = d[e]; } }
    float vn[8][8];
#pragma unroll
    for (int t = 0; t < 8; ++t) {
        const float mt = __shfl(mean, t), rt = __shfl(rstd, t);
        float f[8]; unpack8(vw[t], f);
#pragma unroll
        for (int e = 0; e < 8; ++e) vn[t][e] = (f[e] - mt) * rt * gv[e] + bv[e];
        float* o = p->out + O_VS + ((size_t)(l * 128 + js) * 8 + t) * 1024 + ch0;
        *(f32x4*)o = (f32x4){vn[t][0], vn[t][1], vn[t][2], vn[t][3]}; *(f32x4*)(o + 4) = (f32x4){vn[t][4], vn[t][5], vn[t][6], vn[t][7]};
    }
    const float* W = p->in[22] + ((size_t)l * 16 + g) * 128 * 128; const float* bs = p->in[23] + ((size_t)l * 16 + g) * 128;
#pragma unroll
    for (int t = 0; t < 8; ++t) {
        float o[8]; const float b0 = bs[t];
#pragma unroll
        for (int e = 0; e < 8; ++e) o[e] = b0;
#pragma unroll
        for (int s = 0; s <= t; ++s) { const float ww = W[t * 128 + s];
#pragma unroll
            for (int e = 0; e < 8; ++e) o[e] += ww * vn[s][e]; }
        float uf[8]; unpack8(uw[t], uf);
#pragma unroll
        for (int e = 0; e < 8; ++e) o[e] *= uf[e];
        *(u32x4*)(Z + (size_t)(rb + t) * INC + 1024 + ch0) = pack8(o);
    }
}
__device__ __forceinline__ void lru_item(KP p, int l, int h, int pass, int sample, int idx, unsigned char* smem, int slot) {
    bf16_t* Z = (bf16_t*)(p->ws + WS_Z);
    const int tid = opaque_tid(), lane = tid & 63, wid = tid >> 6, fr = lane & 15, fq = lane >> 4;
    const int hb = idx & 3;
    int s = 0, tt = 0, grp = 0, r0;
    if (!sample) { s = idx >> 7; tt = (idx >> 2) & 31; r0 = s * 2048 + tt * 64; }
    else { grp = idx >> 2; r0 = 8192 + grp * 64; }
    bf16_t* xcb = (bf16_t*)(smem + (sample ? 0 : slot * 65536));
    f32x2* AB = (f32x2*)smem;
    unsigned* AP = (unsigned*)(smem + slot * 65536);
    const int hl = wid >> 1, mb = 32 * (wid & 1), hg = hb * 4 + hl;
    const bf16_t* WT = (const bf16_t*)(p->ws + WS_LRUW) + (size_t)(l * 16 + hg) * 128 * 64;
    bf16x8 Bf[8][2];
#pragma unroll
    for (int ni = 0; ni < 8; ++ni)
#pragma unroll
        for (int ks = 0; ks < 2; ++ks) Bf[ni][ks] = *(const bf16x8*)(WT + (size_t)(ni * 16 + fr) * 64 + ks * 32 + fq * 8);
    float lamv[4], bav[4], bxv[4];
#pragma unroll
    for (int ni = 0; ni < 4; ++ni) { const int ch = l * 1024 + hb * 256 + hl * 64 + ni * 16 + fr; lamv[ni] = p->in[19][ch]; bav[ni] = p->in[16][ch]; bxv[ni] = p->in[18][ch]; }
    {
        const int cgp = tid & 31, rq = tid >> 5, ch = hb * 256 + cgp * 8;
        float rows[7][8];
        u32x4 rw[7];
        if (!sample) {
#pragma unroll
            for (int i = 0; i < 7; ++i) {
                const int lr = 4 * rq - 3 + i;
                if (lr >= 0) rw[i] = *(const u32x4*)(Z + (size_t)(r0 + lr) * INC + ch);
                else if (tt == 0) rw[i] = (u32x4){0u, 0u, 0u, 0u};
                else rw[i] = *(const u32x4*)(Z + (size_t)(r0 + lr) * INC + ch);
            }
#pragma unroll
            for (int i = 0; i < 7; ++i) unpack8(rw[i], rows[i]);
        } else {
            const int j = rq >> 1, tb = (rq & 1) * 4;
#pragma unroll
            for (int i = 0; i < 7; ++i) { const int tp = tb - 3 + i; rw[i] = tp >= 0 ? *(const u32x4*)(Z + (size_t)(r0 + j * 8 + tp) * INC + ch) : (u32x4){0u, 0u, 0u, 0u}; }
#pragma unroll
            for (int i = 0; i < 7; ++i) unpack8(rw[i], rows[i]);
            if (tb == 0) {
                const float* sp = p->in[5] + ((size_t)(l * 128 + 64 * h + grp * 8 + j) * 3) * 1024 + ch;
#pragma unroll
                for (int i = 0; i < 3; ++i) { const f32x4 a = *(const f32x4*)(sp + i * 1024), b = *(const f32x4*)(sp + i * 1024 + 4);
#pragma unroll
                    for (int e = 0; e < 4; ++e) { rows[i][e] = a[e]; rows[i][4 + e] = b[e]; } }
            }
        }
        const float* cw = p->in[13] + (size_t)l * 4 * 1024 + ch; const float* cbias = p->in[14] + (size_t)l * 1024 + ch;
        float wk[4][8], bz[8];
#pragma unroll
        for (int k = 0; k < 4; ++k) { const f32x4 a = *(const f32x4*)(cw + k * 1024), b = *(const f32x4*)(cw + k * 1024 + 4);
#pragma unroll
            for (int e = 0; e < 4; ++e) { wk[k][e] = a[e]; wk[k][4 + e] = b[e]; } }
        { const f32x4 a = *(const f32x4*)cbias, b = *(const f32x4*)(cbias + 4);
#pragma unroll
          for (int e = 0; e < 4; ++e) { bz[e] = a[e]; bz[4 + e] = b[e]; } }
#pragma unroll
        for (int o = 0; o < 4; ++o) {
            float a8[8];
#pragma unroll
            for (int e = 0; e < 8; ++e) a8[e] = bz[e] + wk[0][e] * rows[o][e] + wk[1][e] * rows[o + 1][e] + wk[2][e] * rows[o + 2][e] + wk[3][e] * rows[o + 3][e];
            *(u32x4*)(xcb + (4 * rq + o) * 264 + cgp * 8) = pack8(a8);
        }
        {
            if (!sample) { if (tt == 31 && rq == 15) {
#pragma unroll
                for (int i = 0; i < 3; ++i) { float* o = p->out + O_LCP + ((size_t)(l * 8 + 4 * h + s) * 3 + i) * 1024 + ch;
                    *(f32x4*)o = (f32x4){rows[4 + i][0], rows[4 + i][1], rows[4 + i][2], rows[4 + i][3]}; *(f32x4*)(o + 4) = (f32x4){rows[4 + i][4], rows[4 + i][5], rows[4 + i][6], rows[4 + i][7]}; } } }
            else if (rq & 1) {
                const int js = 64 * h + grp * 8 + (rq >> 1);
#pragma unroll
                for (int i = 0; i < 3; ++i) { float* o = p->out + O_LCS + ((size_t)(l * 128 + js) * 3 + i) * 1024 + ch;
                    *(f32x4*)o = (f32x4){rows[4 + i][0], rows[4 + i][1], rows[4 + i][2], rows[4 + i][3]}; *(f32x4*)(o + 4) = (f32x4){rows[4 + i][4], rows[4 + i][5], rows[4 + i][6], rows[4 + i][7]}; }
            }
        }
    }
    __syncthreads();
    f32x4 acc[2][8];
#pragma unroll
    for (int a = 0; a < 2; ++a)
#pragma unroll
        for (int b = 0; b < 8; ++b) acc[a][b] = (f32x4){0.f, 0.f, 0.f, 0.f};
    bf16x8 Af[2][2];
#pragma unroll
    for (int mi = 0; mi < 2; ++mi)
#pragma unroll
        for (int ks = 0; ks < 2; ++ks) Af[mi][ks] = *(const bf16x8*)(xcb + (mb + mi * 16 + fr) * 264 + hl * 64 + ks * 32 + fq * 8);
#pragma unroll
    for (int ni = 0; ni < 8; ++ni)
#pragma unroll
        for (int ks = 0; ks < 2; ++ks)
#pragma unroll
            for (int mi = 0; mi < 2; ++mi) acc[mi][ni] = __builtin_amdgcn_mfma_f32_16x16x32_bf16(Af[mi][ks], Bf[ni][ks], acc[mi][ni], 0, 0, 0);
    float av[2][4][4], bv[2][4][4];
#pragma unroll
    for (int ni = 0; ni < 4; ++ni) {
        const int chl = hl * 64 + ni * 16 + fr;
        const float sp = 0.69314718f * __builtin_amdgcn_logf(1.f + __builtin_amdgcn_exp2f(-1.44269504f * lamv[ni]));
        const float ka = -8.f * 1.44269504f * sp, car_ = -1.44269504f * bav[ni], cxi = -1.44269504f * bxv[ni];
#pragma unroll
        for (int mi = 0; mi < 2; ++mi)
#pragma unroll
            for (int jj = 0; jj < 4; ++jj) {
                const int row = mb + mi * 16 + 4 * fq + jj;
                const float er = 1.f + __builtin_amdgcn_exp2f(fminf(-1.44269504f * acc[mi][ni][jj] + car_, 60.f));
                const float ei = 1.f + __builtin_amdgcn_exp2f(fminf(-1.44269504f * acc[mi][ni + 4][jj] + cxi, 60.f));
                const float inv = __builtin_amdgcn_rcpf(er * ei);
                const float rg = inv * ei, ig = inv * er;
                const float xv = bf2f(xcb[row * 264 + chl]);
                float tq = ka * rg;
                if (!sample) tq = (float)(_Float16)tq;
                const float a = __builtin_amdgcn_exp2f(tq);
                av[mi][ni][jj] = sample ? a : tq;
                bv[mi][ni][jj] = __builtin_amdgcn_sqrtf(fmaxf(1.f - a * a, 0.f)) * ig * xv;
            }
    }
    const int chs = hb * 256 + (tid & 255);
    float h0s[8];
    if (sample && tid < 256) {
#pragma unroll
        for (int j = 0; j < 8; ++j) h0s[j] = p->in[4][(size_t)(l * 128 + 64 * h + grp * 8 + j) * 1024 + chs];
    }
    __syncthreads();
#pragma unroll
    for (int ni = 0; ni < 4; ++ni)
#pragma unroll
        for (int mi = 0; mi < 2; ++mi)
#pragma unroll
            for (int jj = 0; jj < 4; ++jj) {
                const int e_ = (mb + mi * 16 + 4 * fq + jj) * 256 + hl * 64 + ni * 16 + fr;
                if (sample) AB[e_] = (f32x2){av[mi][ni][jj], bv[mi][ni][jj]};
                else { const _Float16 th = (_Float16)av[mi][ni][jj]; AP[e_] = (unsigned)__builtin_bit_cast(unsigned short, th) | (pk2(0.f, bv[mi][ni][jj]) & 0xffff0000u); }
            }
    __syncthreads();
    if (tid < 256) {
        if (!sample) {
            float hh = 0.f, P = 1.f;
#pragma unroll 16
            for (int row = 0; row < 64; ++row) { const unsigned w = AP[row * 256 + tid]; const float a = __builtin_amdgcn_exp2f((float)__builtin_bit_cast(_Float16, (unsigned short)(w & 0xffffu))); hh = a * hh + hi_f(w); P *= a; }
            *(f32x2*)((float*)(p->ws + WS_CAR) + ((size_t)(s * 32 + tt) * 1024 + chs) * 2) = (f32x2){P, hh};
        } else {
#pragma unroll
            for (int j = 0; j < 8; ++j) {
                float hh = h0s[j];
#pragma unroll
                for (int t = 0; t < 8; ++t) { const int row = j * 8 + t; const f32x2 ab = AB[row * 256 + tid]; hh = ab.x * hh + ab.y; AB[row * 256 + tid].x = hh; }
                p->out[O_HS + (size_t)(l * 128 + 64 * h + grp * 8 + j) * 1024 + chs] = hh;
            }
        }
    }
    __syncthreads();
    if (sample) {
#pragma unroll
        for (int i = 0; i < 8; ++i) {
            const int row = wid * 8 + i;
#pragma unroll
            for (int j = 0; j < 2; ++j) {
                const f32x4 v = *(const f32x4*)&AB[row * 256 + (lane + 64 * j) * 2];
                *(unsigned*)(Z + (size_t)(r0 + row) * INC + hb * 256 + (lane + 64 * j) * 2) = pk2(v[0], v[2]);
            }
        }
        __syncthreads();
    }
}

__device__ __forceinline__ void lru_finish(KP p, int l, int h, int idx, unsigned char* smem, int slot) {
    bf16_t* Z = (bf16_t*)(p->ws + WS_Z);
    const int tid = opaque_tid(), lane = tid & 63, wid = tid >> 6;
    const int hb = idx & 3, s = idx >> 7, tt = (idx >> 2) & 31, r0 = s * 2048 + tt * 64;
    unsigned* AP = (unsigned*)(smem + slot * 65536);
    if (tid < 256) {
        const int chs = hb * 256 + tid;
        const float* car = (const float*)(p->ws + WS_CAR);
        f32x2 cr[31];
#pragma unroll
        for (int k = 0; k < 31; ++k) if (k < tt) cr[k] = *(const f32x2*)(car + ((size_t)(s * 32 + k) * 1024 + chs) * 2);
        float hh = 0.f;
#pragma unroll
        for (int k = 0; k < 31; ++k) if (k < tt) hh = cr[k].x * hh + cr[k].y;
#pragma unroll 16
        for (int row = 0; row < 64; ++row) { const unsigned w = AP[row * 256 + tid]; const float a = __builtin_amdgcn_exp2f((float)__builtin_bit_cast(_Float16, (unsigned short)(w & 0xffffu))); hh = a * hh + hi_f(w); AP[row * 256 + tid] = __float_as_uint(hh); }
        if (tt == 31) p->out[O_HP + (size_t)(l * 8 + 4 * h + s) * 1024 + chs] = hh;
    }
    __syncthreads();
#pragma unroll
    for (int i = 0; i < 8; ++i) {
        const int row = wid * 8 + i;
        const f32x4 v = *(const f32x4*)(const void*)&AP[row * 256 + lane * 4];
        u32x2 o; o.x = pk2(v[0], v[1]); o.y = pk2(v[2], v[3]);
        *(u32x2*)(Z + (size_t)(r0 + row) * INC + hb * 256 + lane * 4) = o;
    }
    __syncthreads();
}

#ifndef PHM
#define PHM 0xFFFF
#endif
#ifndef NSYNC
#define NSYNC 1
#endif
#define GSYNC do { FRESH_P; XcdBarrier xb_; xb_.bar = (unsigned*)(p->ws + WS_BAR); xb_.x = xb_xcc_id(); xb_.st = (volatile LAS unsigned*)((LAS unsigned char*)smem + 131072); xcd_barrier(xb_); } while (0)
__global__ void __launch_bounds__(512) mega(Params p_unused) {
    cg::grid_group grid = cg::this_grid();
    extern __shared__ __attribute__((aligned(16))) unsigned char smem[];
    LAS unsigned char* lds = (LAS unsigned char*)smem;
    volatile LAS unsigned* xst = (volatile LAS unsigned*)(lds + 131072);
    if (threadIdx.x == 0) { xst[0] = 0u; xst[1] = 0u; }
    __syncthreads();
    { FRESH_P; (void)xcd_barrier_post((unsigned*)(p->ws + WS_BAR), xst); }

    if (PHM & 1) { FRESH_P; p0_convert(p, smem, 0, blockIdx.x, gridDim.x); }
    { FRESH_P; if (p->ws == nullptr) grid.sync(); }
    GSYNC;
    if (PHM & 3) {
        FRESH_P;
        if (blockIdx.x < 48) {
            unsigned char* ws = p->ws;
            pg8::Gemm g{(const bf16_t*)(ws + WS_CA), (const bf16_t*)(ws + WS_Z), 1024, 1024, 1024, 0, 0};
            pg8::Order S; S.init(1, 48, 1, gridDim.x, blockIdx.x, 16);
            EpiMod E{(float*)(ws + WS_MOD), p->in[8]};
            pg8::gemm_phase(lds, g, S, E);
        } else p0_convert(p, smem, 1, blockIdx.x - 48, gridDim.x - 48);
    }
    GSYNC;
    if (PHM & 2) { FRESH_P; derive_pass(p, blockIdx.x, gridDim.x); }
    GSYNC;
    if (PHM & 4) {
        FRESH_P; unsigned char* ws = p->ws;
        const int G = gridDim.x, bid = blockIdx.x;
        int off = 0;
        for (int q = 0; q < 6; ++q) {
            const int l = q / 3, kind = q % 3, N = kind == 0 ? 6144 : (kind == 1 ? 3072 : DFF);
            const bf16_t* Bt = kind == 0 ? (const bf16_t*)(ws + WS_WIN) + (size_t)l * 6144 * 1024
                             : kind == 1 ? (const bf16_t*)(ws + WS_Z + ZT_GATE) + (size_t)l * 3072 * 1024 : (const bf16_t*)(ws + WS_WF1) + (size_t)l * DFF * 1024;
            pg8::Gemm g{(const bf16_t*)(ws + WS_SHA) + (size_t)(l * 2 + (kind == 2)) * 256 * 1024, Bt, 1024, 1024, 1024, 0, 0};
            pg8::Order S; S.init(1, N / 256, 1, G, (bid - off + G) % G, 16);
            EpiSW E{kind == 2 ? (float*)(ws + WS_SW2) + (size_t)l * NBATCH * DFF : (float*)(ws + WS_SW1) + (size_t)l * NBATCH * INC + (kind == 1 ? 6144 : 0), kind == 2 ? DFF : INC};
            pg8::gemm_phase(lds, g, S, E);
            off = (off + N / 256) % G;
        }
        if (bid >= 104) xg0_pass(p, 0, bid - 104, G - 104);
    }
    GSYNC;

    for (int hl = 0; hl < 4; ++hl) {
        int h = hl >> 1, l = hl & 1;
        asm volatile("" : "+s"(h), "+s"(l));
        if (PHM & 8) {
            FRESH_P; unsigned char* ws = p->ws;
            {
                pg8::Gemm g{(const bf16_t*)(ws + WS_XG), (const bf16_t*)(ws + WS_WIN) + (size_t)l * 6144 * 1024, 1024, 1024, 1024, 0, 0};
                pg8::Order S; S.init(34, 24, 1, gridDim.x, blockIdx.x, 16);
                EpiG1 E{(bf16_t*)(ws + WS_Z), (const float*)(ws + WS_RSA), (const float*)(ws + WS_SW1) + (size_t)l * NBATCH * INC, h, (float*)(ws + WS_VS), 0};
                pg8::gemm_phase(lds, g, S, E);
            }
            {
                pg8::Gemm g{(const bf16_t*)(ws + WS_XG8), (const bf16_t*)(ws + WS_W8) + (size_t)l * 3072 * 512, 512, 512, 512, 0, 0};
                pg8::Order S; S.init(34, 12, 1, (int)gridDim.x - 48, blockIdx.x >= 48 ? (int)blockIdx.x - 48 : (1 << 28), 8);
                EpiGate E{(bf16_t*)(ws + WS_Z), (const float*)(ws + WS_RSA), (const float*)(ws + WS_SW1) + (size_t)l * NBATCH * INC, h};
                pg8::gemm_phase<EpiGate, pg8::Order, true>(lds, g, S, E);
            }
        }
        GSYNC;
        if (PHM & 16) {
            FRESH_P;
            for (int it = blockIdx.x; it < 256 + 16; it += gridDim.x) {
                if (it < 256) mixB_prompt_item(p, l, it, smem);
                else mixB_sample_item(p, l, h, it - 256);
            }
#pragma unroll 1
            for (int slot = 0; slot < 2; ++slot) lru_item(p, l, h, 1, 0, blockIdx.x + 256 * slot, smem, slot);
        }
        GSYNC;
        if (PHM & 32) {
            FRESH_P;
#pragma unroll 1
            for (int slot = 0; slot < 2; ++slot) lru_finish(p, l, h, blockIdx.x + 256 * slot, smem, slot);
            if (blockIdx.x < 32) lru_item(p, l, h, 2, 1, blockIdx.x, smem, 0);
            else for (int it = blockIdx.x - 32; it < 272; it += gridDim.x - 32) mixC_item(p, l, h, it);
        }
        GSYNC;
        if (PHM & 64) {
            FRESH_P; unsigned char* ws = p->ws; bf16_t* Z = (bf16_t*)(ws + WS_Z);
            pg8::Gemm g{Z, (const bf16_t*)(ws + WS_WBR) + (size_t)l * 3 * 1024 * 1024, INC, 1024, 1024, 1024, (size_t)1024 * 1024};
            pg8::Order S; S.init(34, 4, 3, gridDim.x, blockIdx.x, 16);
            EpiBR E{Z};
            pg8::gemm_phase(lds, g, S, E);
        }
        GSYNC;
        if (PHM & 64) { FRESH_P; sum_pass(p); }
        GSYNC;
        if (PHM & 128) {
            FRESH_P; unsigned char* ws = p->ws;
            pg8::Gemm g{(const bf16_t*)(ws + WS_Z) + 6144, (const bf16_t*)(ws + WS_WO3) + (size_t)l * 1024 * 1024, INC, 1024, 1024, 0, 0};
            pg8::Order S; S.init(34, 4, 1, gridDim.x, blockIdx.x, 16);
            EpiRes<false> E{p->in[0], p->in[1], p->out, (const float*)(ws + WS_MOD) + l * 6144 + 2048, (const float*)(ws + WS_GB) + (size_t)(l * 2 + 1) * NBATCH * 1024,
                     (bf16_t*)(ws + WS_XG), (float*)(ws + WS_RSB), h, l == 0, 0, nullptr, nullptr, nullptr, 0};
            pg8::gemm_phase(lds, g, S, E);
            if (h == 1 && l == 0 && blockIdx.x >= 136) final_pass(p, 0, blockIdx.x - 136, gridDim.x - 136);
        }
        GSYNC;
        if (PHM & 256) {
            FRESH_P; unsigned char* ws = p->ws;
            pg8::Gemm g{(const bf16_t*)(ws + WS_XG), (const bf16_t*)(ws + WS_WF1) + (size_t)l * DFF * 1024, 1024, 1024, 1024, 0, 0};
            pg8::Order S; S.init(32, 16, 1, gridDim.x, blockIdx.x, 16);
            EpiFF1 E{(bf16_t*)(ws + WS_Z), (const float*)(ws + WS_RSB), (const float*)(ws + WS_SW2) + (size_t)l * NBATCH * DFF, h, nullptr};
            pg8::gemm_phase(lds, g, S, E);
        }
        GSYNC;
        if (PHM & 512) {
            FRESH_P; unsigned char* ws = p->ws;
            unsigned* skf = (unsigned*)(ws + WS_BAR + 16384) + (h * 2 + l) * 256;
            unsigned* pdone = (unsigned*)(ws + WS_BAR + 16384 + 8192) + (h * 2 + l) * 64;
            if (blockIdx.x >= 224) {
                const int j = (int)blockIdx.x - 224;
                {
                    pg8::Gemm g{(const bf16_t*)(ws + WS_XG), (const bf16_t*)(ws + WS_WF1) + (size_t)l * DFF * 1024, 1024, 1024, 1024, 0, 0};
                    pg8::OrderOne S1{32 + (j >> 4), j & 15, 16};
                    EpiFF1 E{(bf16_t*)(ws + WS_Z), (const float*)(ws + WS_RSB), (const float*)(ws + WS_SW2) + (size_t)l * NBATCH * DFF, h, pdone + (j >> 4) * 32};
                    pg8::gemm_phase(lds, g, S1, E);
                }
                if (threadIdx.x < 64) {
                    unsigned sp = 0;
                    while (xb_ld(pdone + (j >> 4) * 32) < 16u) { __builtin_amdgcn_s_sleep(2); if (++sp > (1u << 22)) break; }
                    __builtin_amdgcn_fence(__ATOMIC_ACQUIRE, "agent");
                    asm volatile("s_waitcnt vmcnt(0)" ::: "memory");
                }
                __syncthreads();
            }
            pg8::Gemm g{(const bf16_t*)(ws + WS_Z), (const bf16_t*)(ws + WS_WF2) + (size_t)l * 1024 * DFF, DFF, DFF, DFF, 0, 0};
            pg8::OrderSK S; S.c = blockIdx.x;
            EpiRes<true> E{nullptr, nullptr, p->out, (const float*)(ws + WS_MOD) + l * 6144 + 5120, l == 0 ? (const float*)(ws + WS_GB) + (size_t)2 * NBATCH * 1024 : nullptr,
                     (bf16_t*)(ws + WS_XG), l == 0 ? (float*)(ws + WS_RSA) : (float*)(ws + WS_RSF), h, 0, l == 1, ws + WS_XG8,
                     (float*)(ws + WS_Z + (72ull << 20)), skf, (int)blockIdx.x};
            pg8::gemm_phase(lds, g, S, E);
            if (h == 0 && l == 1 && blockIdx.x < 224) xg0_pass(p, 1, blockIdx.x, 224);
        }
        GSYNC;
    }
    if (PHM & 1024) { FRESH_P; final_pass(p, 1, blockIdx.x, gridDim.x); }
}

extern "C" void kernel_launch(void* const* d_in, const int* in_sizes, int n_in, void* d_out, int out_size, void* d_ws, size_t ws_size, hipStream_t stream) {
    static int grid_blocks = 0;
    if (grid_blocks == 0) {
        if (n_in != 31 || ws_size < WS_END) { fprintf(stderr, "kernel_launch: need 31 inputs and %zu bytes of workspace, got %d / %zu\n", (size_t)WS_END, n_in, ws_size); grid_blocks = -1; return; }
        int dev = 0, cus = 0, per_cu = 0;
        hipGetDevice(&dev);
        hipDeviceGetAttribute(&cus, hipDeviceAttributeMultiprocessorCount, dev);
        hipFuncSetAttribute((const void*)mega, hipFuncAttributeMaxDynamicSharedMemorySize, LDS_BYTES);
        hipOccupancyMaxActiveBlocksPerMultiprocessor(&per_cu, (const void*)mega, 512, LDS_BYTES);
        if (per_cu < 1) { fprintf(stderr, "kernel_launch: occupancy query says %d blocks per CU\n", per_cu); per_cu = 1; }
        if (per_cu > 1) per_cu = 1;
        grid_blocks = cus * per_cu;
        if (grid_blocks != 256) { fprintf(stderr, "kernel_launch: built for a 256-CU device, got %d\n", grid_blocks); if (grid_blocks > 256) grid_blocks = 256; else { grid_blocks = -1; return; } }
    }
    if (grid_blocks < 0) return;
    Params p{};
    for (int i = 0; i < 31; ++i) p.in[i] = (const float*)d_in[i];
    p.out = (float*)d_out; p.ws = (unsigned char*)d_ws;
    if (hipMemsetAsync((unsigned char*)d_ws + WS_BAR, 0, 32768, stream) != hipSuccess) { fprintf(stderr, "kernel_launch: memset of the barrier words failed\n"); return; }
    void* args[] = {&p};
    hipError_t e = hipLaunchCooperativeKernel((const void*)mega, dim3(grid_blocks), dim3(512), args, LDS_BYTES, stream);
    if (e != hipSuccess) fprintf(stderr, "cooperative launch failed: %s (grid %d)\n", hipGetErrorString(e), grid_blocks);
}
```
